# Optimizing an MI355X kernel written in HIP

```python
import math
import jax, jax.numpy as jnp
from jax import lax
import numpy as np

D_MODEL = 4096
BATCH = 2
SEQ = 8192
DEPTH = 2

N_A_LAYERS = DEPTH // 2
N_B_LAYERS = DEPTH - N_A_LAYERS
HEAD_DIM = 128
DIFF_HEADS = D_MODEL // (2 * HEAD_DIM)
DIFF_MAPS = 2 * DIFF_HEADS
SWA_Q_HEADS = D_MODEL // HEAD_DIM
SWA_KV_HEADS = SWA_Q_HEADS // 4
SWA_GROUP = SWA_Q_HEADS // SWA_KV_HEADS
WINDOW = 128
BLOCK = 128
D_FF = -(-8 * D_MODEL // (3 * 256)) * 256
NUM_BUCKETS = 32
MAX_DISTANCE = 128
BIAS_HEADS = SWA_Q_HEADS
EPS = 1e-6
NEG = -1e30

kernel_name = 'hybrid_diffattn_swa_sinks_yoco'


def rms_norm(x, g):
    xf = x.astype(jnp.float32)
    y = xf * lax.rsqrt(jnp.mean(xf * xf, axis=-1, keepdims=True) + EPS)
    return (y * g.astype(jnp.float32)).astype(x.dtype)


def t5_bucket(n):
    max_exact = NUM_BUCKETS // 2
    nf = jnp.maximum(n, 1).astype(jnp.float32)
    large = max_exact + (jnp.log(nf / max_exact) / math.log(MAX_DISTANCE / max_exact)
                         * (NUM_BUCKETS - max_exact)).astype(jnp.int32)
    large = jnp.minimum(large, NUM_BUCKETS - 1)
    return jnp.where(n < max_exact, n, large)


def distance_bias_table(rel_bias):
    return rel_bias[t5_bucket(jnp.arange(MAX_DISTANCE))]


def bias_from_distance(lut, dist):
    return jnp.moveaxis(lut[jnp.clip(dist, 0, MAX_DISTANCE - 1)], -1, 0).astype(jnp.float32)


def swiglu(h, w_gate, w_up, w_down):
    return (jax.nn.silu(h @ w_gate) * (h @ w_up)) @ w_down


def diff_attention(h, w_qkv, w_o, g_q, g_k, lam_qk, g_sub, lut, lambda_init):
    B, S, _ = h.shape
    nb = S // BLOCK
    q, k, v = jnp.split(h @ w_qkv, 3, axis=-1)
    q = rms_norm(q.reshape(B, S, DIFF_MAPS, HEAD_DIM), g_q)
    k = rms_norm(k.reshape(B, S, DIFF_MAPS, HEAD_DIM), g_k)
    v = v.reshape(B, S, DIFF_HEADS, 2 * HEAD_DIM)
    lf = lam_qk.astype(jnp.float32)
    lam = jnp.exp(jnp.sum(lf[0] * lf[1])) - jnp.exp(jnp.sum(lf[2] * lf[3])) + lambda_init
    scale = HEAD_DIM ** -0.5
    q_blocks = q.reshape(B, nb, BLOCK, DIFF_MAPS, HEAD_DIM).transpose(1, 0, 2, 3, 4)
    key_pos = jnp.arange(S)

    def one_block(args):
        qb, bi = args
        logits = jnp.einsum('bqmd,bkmd->bmqk', qb, k,
                            preferred_element_type=jnp.float32) * scale
        dist = (bi * BLOCK + jnp.arange(BLOCK))[:, None] - key_pos[None, :]
        logits = logits + bias_from_distance(lut, dist)[None]
        logits = jnp.where(dist >= 0, logits, NEG)
        p = jax.nn.softmax(logits, axis=-1).reshape(B, DIFF_HEADS, 2, BLOCK, S)
        a = p[:, :, 0] - lam * p[:, :, 1]
        return jnp.einsum('bhqk,bkhe->bqhe', a.astype(v.dtype), v)

    o = lax.map(one_block, (q_blocks, jnp.arange(nb)))
    o = o.transpose(1, 0, 2, 3, 4).reshape(B, S, DIFF_HEADS, 2 * HEAD_DIM)
    o = rms_norm(o, g_sub) * (1.0 - lambda_init)
    return o.reshape(B, S, D_MODEL) @ w_o


def swa_sinks_attention(h, w_q, w_o, g_q, k, v, sinks, lut):
    B, S, _ = h.shape
    nb = S // BLOCK
    q = rms_norm((h @ w_q).reshape(B, S, SWA_Q_HEADS, HEAD_DIM), g_q)
    q = q.reshape(B, nb, BLOCK, SWA_KV_HEADS, SWA_GROUP, HEAD_DIM)

    def with_prev(t):
        t = t.reshape(B, nb, BLOCK, SWA_KV_HEADS, HEAD_DIM)
        prev = jnp.pad(t[:, :-1], ((0, 0), (1, 0), (0, 0), (0, 0), (0, 0)))
        return jnp.concatenate([prev, t], axis=2)

    kk, vv = with_prev(k), with_prev(v)
    logits = jnp.einsum('bnqgrd,bnkgd->bngrqk', q, kk,
                        preferred_element_type=jnp.float32) * (HEAD_DIM ** -0.5)
    qi = jnp.arange(BLOCK)[:, None]
    kj = jnp.arange(2 * BLOCK)[None, :]
    dist = BLOCK + qi - kj
    bias = bias_from_distance(lut, dist).reshape(SWA_KV_HEADS, SWA_GROUP, BLOCK, 2 * BLOCK)
    logits = logits + bias
    valid = ((dist >= 0) & (dist < WINDOW))[None] & (
        (jnp.arange(nb)[:, None, None] > 0) | (kj[None] >= BLOCK))
    logits = jnp.where(valid[None, :, None, None], logits, NEG)
    sink = jnp.broadcast_to(
        sinks.astype(jnp.float32).reshape(1, 1, SWA_KV_HEADS, SWA_GROUP, 1, 1),
        logits.shape[:-1] + (1,))
    p = jax.nn.softmax(jnp.concatenate([logits, sink], axis=-1), axis=-1)[..., :-1]
    o = jnp.einsum('bngrqk,bnkgd->bnqgrd', p.astype(vv.dtype), vv)
    return o.reshape(B, S, D_MODEL) @ w_o


def setup_inputs(seed: int = 0) -> dict:
    key = jax.random.key(seed)
    ks = jax.random.split(key, 24)
    f32 = jnp.float32

    def w(k, shape, fan_in):
        return jax.random.normal(k, shape, f32) * (fan_in ** -0.5)

    def gain(k, shape):
        return 1.0 + 0.02 * jax.random.normal(k, shape, f32)

    kv_width = SWA_KV_HEADS * HEAD_DIM
    return {
        'x': jax.random.normal(ks[0], (BATCH, SEQ, D_MODEL), f32),
        'rel_bias': 0.5 * jax.random.normal(ks[1], (NUM_BUCKETS, BIAS_HEADS), f32),
        'g_attn_norm': gain(ks[2], (DEPTH, D_MODEL)),
        'g_ffn_norm': gain(ks[3], (DEPTH, D_MODEL)),
        'w_qkv_a': w(ks[4], (N_A_LAYERS, D_MODEL, 3 * D_MODEL), D_MODEL),
        'w_o_a': w(ks[5], (N_A_LAYERS, D_MODEL, D_MODEL), D_MODEL),
        'g_q_a': gain(ks[6], (N_A_LAYERS, HEAD_DIM)),
        'g_k_a': gain(ks[7], (N_A_LAYERS, HEAD_DIM)),
        'lam_qk_a': 0.1 * jax.random.normal(ks[8], (N_A_LAYERS, 4, HEAD_DIM), f32),
        'g_sub_a': gain(ks[9], (N_A_LAYERS, 2 * HEAD_DIM)),
        'g_kv_norm': gain(ks[10], (D_MODEL,)),
        'w_kv': w(ks[11], (D_MODEL, 2 * kv_width), D_MODEL),
        'g_k_shared': gain(ks[12], (HEAD_DIM,)),
        'w_q_b': w(ks[13], (N_B_LAYERS, D_MODEL, D_MODEL), D_MODEL),
        'w_o_b': w(ks[14], (N_B_LAYERS, D_MODEL, D_MODEL), D_MODEL),
        'g_q_b': gain(ks[15], (N_B_LAYERS, HEAD_DIM)),
        'sinks_b': 0.5 * jax.random.normal(ks[16], (N_B_LAYERS, SWA_Q_HEADS), f32),
        'w_gate': w(ks[17], (DEPTH, D_MODEL, D_FF), D_MODEL),
        'w_up': w(ks[18], (DEPTH, D_MODEL, D_FF), D_MODEL),
        'w_down': w(ks[19], (DEPTH, D_FF, D_MODEL), D_FF),
    }


def reference(x, rel_bias, g_attn_norm, g_ffn_norm, w_qkv_a, w_o_a, g_q_a, g_k_a,
              lam_qk_a, g_sub_a, g_kv_norm, w_kv, g_k_shared, w_q_b, w_o_b, g_q_b,
              sinks_b, w_gate, w_up, w_down):
    B, S, _ = x.shape
    lut = distance_bias_table(rel_bias)
    k_sh = None
    v_sh = None
    for i in range(DEPTH):
        h = rms_norm(x, g_attn_norm[i])
        if i < N_A_LAYERS:
            a = i
            lambda_init = 0.8 - 0.6 * math.exp(-0.3 * i)
            x = x + diff_attention(h, w_qkv_a[a], w_o_a[a], g_q_a[a], g_k_a[a],
                                   lam_qk_a[a], g_sub_a[a], lut, lambda_init)
        else:
            b = i - N_A_LAYERS
            x = x + swa_sinks_attention(h, w_q_b[b], w_o_b[b], g_q_b[b],
                                        k_sh, v_sh, sinks_b[b], lut)
        x = x + swiglu(rms_norm(x, g_ffn_norm[i]), w_gate[i], w_up[i], w_down[i])
        if i == N_A_LAYERS - 1:
            k_sh, v_sh = jnp.split(rms_norm(x, g_kv_norm) @ w_kv, 2, axis=-1)
            k_sh = rms_norm(k_sh.reshape(B, S, SWA_KV_HEADS, HEAD_DIM), g_k_shared)
            v_sh = v_sh.reshape(B, S, SWA_KV_HEADS, HEAD_DIM)
    return x
```

```cpp
#include <hip/hip_runtime.h>
#include <hip/hip_bf16.h>
#include <cstdio>
#include <cstdint>
#include <cmath>
namespace pg8 {
#define PG8_LAS __attribute__((address_space(3)))
typedef unsigned short bf16_t;
typedef short bf16x8 __attribute__((ext_vector_type(8)));
typedef float f32x4 __attribute__((ext_vector_type(4)));
typedef unsigned u32x4 __attribute__((ext_vector_type(4)));
constexpr int BM = 256, BK = 64, HALF = 128, HTB = HALF * BK * 2  , STAGE_BYTES = 8 * HTB, NXCD = 8, WGM = 8;

__host__ __device__ __forceinline__ int lds_byte(int r, int c) { const int st = (r >> 4) * 2 + (c >> 5), rr = r & 15, cc = c & 31, ob = rr * 64 + cc * 2; return st * 1024 + (ob ^ (((ob >> 9) & 1) << 5)); }
__host__ __device__ __forceinline__ void stage_rc(int b, int& R, int& C) { const int st = b / 1024, sb = b % 1024, swz = sb ^ (((sb >> 9) & 1) << 5); R = (st >> 1) * 16 + swz / 64; C = (st & 1) * 32 + (swz % 64) / 2; }
__host__ __device__ __forceinline__ int perm32(int rho) { const int n = rho >> 4, i = rho & 15; return 8 * (i >> 2) + 4 * n + (i & 3); }

struct Unit { int pm, pn; };
struct Gemm { const bf16_t* A; const bf16_t* Bt; int M, N, K, lda; };

struct StaticOrder {
    int nM, nN, nwg, G, c;
    __host__ __device__ void init(int M, int N, int G_, int c_) { nM = M / BM; nN = N / BM; nwg = nM * nN; G = G_; c = c_; }
    __host__ __device__ bool next(int i, Unit& u) const {
        const long L = (long)i * G + c; if (L >= nwg) return false;
        int wgid = (int)L; { const int q = nwg / NXCD, r = nwg % NXCD, xcd = wgid % NXCD, off = wgid / NXCD; wgid = (xcd < r ? xcd * (q + 1) : r * (q + 1) + (xcd - r) * q) + off; }
        const int nig = WGM * nN, gid = wgid / nig, fm = gid * WGM, gsz = (nM - fm) < WGM ? (nM - fm) : WGM;
        u.pm = fm + ((wgid % nig) % gsz); u.pn = (wgid % nig) / gsz; return true;
    }
    __device__ __forceinline__ void a_ready(const Unit&) const {}
    __device__ __forceinline__ void done(const Unit&) const {}
};

__device__ __forceinline__ unsigned cvt_pk_bf16(float lo, float hi) { unsigned r; asm volatile("v_cvt_pk_bf16_f32 %0, %1, %2" : "=v"(r) : "v"(lo), "v"(hi)); return r; }
typedef float f32x2 __attribute__((ext_vector_type(2)));
struct EpiStoreBf16 {
    static constexpr bool PERM = true, AFTER_DRAIN = false;
    bf16_t* O; int ldc;
    __device__ __forceinline__ void operator()(const f32x4 (&acc)[2][2][4][2], const Unit& u, int wr, int wc, int fr, int fq) const {
        const int row0 = u.pm * BM + wr * 64 + fr, col0 = u.pn * BM + wc * 32 + 8 * fq;
#pragma unroll
        for (int ai = 0; ai < 2; ++ai)
#pragma unroll
            for (int m = 0; m < 4; ++m) { bf16_t* rowp = O + (size_t)(row0 + ai * HALF + m * 16) * ldc + col0;
#pragma unroll
                for (int bj = 0; bj < 2; ++bj) { const f32x4 v0 = acc[ai][bj][m][0], v1 = acc[ai][bj][m][1];
                    u32x4 w; w.x = cvt_pk_bf16(v0[0], v0[1]); w.y = cvt_pk_bf16(v0[2], v0[3]); w.z = cvt_pk_bf16(v1[0], v1[1]); w.w = cvt_pk_bf16(v1[2], v1[3]);
                    *(u32x4*)(rowp + bj * HALF) = w; } }
    }
};
struct EpiSwiGLU {
    static constexpr bool PERM = true, AFTER_DRAIN = false;
    bf16_t* O; int ldc;
    __device__ __forceinline__ void operator()(const f32x4 (&acc)[2][2][4][2], const Unit& u, int wr, int wc, int fr, int fq) const {
        const int row0 = u.pm * BM + wr * 64 + fr, col0 = u.pn * HALF + wc * 32 + 8 * fq;
#pragma unroll
        for (int ai = 0; ai < 2; ++ai)
#pragma unroll
            for (int m = 0; m < 4; ++m) { bf16_t* rowp = O + (size_t)(row0 + ai * HALF + m * 16) * ldc + col0;
                float r[8];
#pragma unroll
                for (int n = 0; n < 2; ++n)
#pragma unroll
                    for (int e = 0; e < 4; ++e) { const float g = acc[ai][0][m][n][e], up = acc[ai][1][m][n][e];
                        const float s = __builtin_amdgcn_rcpf(1.0f + __builtin_amdgcn_exp2f(-1.4426950408889634f * g));
                        r[n * 4 + e] = g * s * up; }
                u32x4 w; w.x = cvt_pk_bf16(r[0], r[1]); w.y = cvt_pk_bf16(r[2], r[3]); w.z = cvt_pk_bf16(r[4], r[5]); w.w = cvt_pk_bf16(r[6], r[7]);
                *(u32x4*)rowp = w; }
    }
};
struct EpiResF32 {
    static constexpr bool PERM = false, AFTER_DRAIN = false;
    const float* res; float* out; int ldc;
    __device__ __forceinline__ void operator()(const f32x4 (&acc)[2][2][4][2], const Unit& u, int wr, int wc, int fr, int fq) const {
        const int row0 = u.pm * BM + wr * 64 + fr, col0 = u.pn * BM + wc * 32 + 4 * fq;
#pragma unroll
        for (int ai = 0; ai < 2; ++ai)
#pragma unroll
            for (int m = 0; m < 4; ++m) { const size_t off = (size_t)(row0 + ai * HALF + m * 16) * ldc + col0;
                f32x4 rv[2][2];
#pragma unroll
                for (int bj = 0; bj < 2; ++bj)
#pragma unroll
                    for (int n = 0; n < 2; ++n) rv[bj][n] = *(const f32x4*)(res + off + bj * HALF + n * 16);
#pragma unroll
                for (int bj = 0; bj < 2; ++bj)
#pragma unroll
                    for (int n = 0; n < 2; ++n) *(f32x4*)(out + off + bj * HALF + n * 16) = rv[bj][n] + acc[ai][bj][m][n]; }
    }
};
template <class Epi, class Sched, bool ALIGN_EPI = false, bool SP2 = false>
__device__ __forceinline__ void gemm_phase(PG8_LAS unsigned char* lds, const Gemm g, const Sched& S, const Epi& E) {
    int tid = threadIdx.x; asm volatile("" : "+v"(tid));
    const int wid = __builtin_amdgcn_readfirstlane(tid >> 6), lane = tid & 63, wr = wid >> 2, wc = wid & 3, fr = lane & 15, fq = lane >> 4;
    const int K = g.K, nt = K / BK;
    unsigned voffA[2], voffB[2];
#pragma unroll
    for (int i = 0; i < 2; ++i) { int R, C; stage_rc(tid * 16 + i * 8192, R, C); const int Rb = Epi::PERM ? ((R & ~31) + perm32(R & 31)) : R;
        voffA[i] = (unsigned)(R * g.lda + C) * 2u; voffB[i] = (unsigned)(Rb * K + C) * 2u; }
    const size_t kstep = (size_t)(BK * 2);
    const size_t hstep = (size_t)HALF * K * 2;
    const size_t hstepA = (size_t)HALF * g.lda * 2, tstepA = 2 * hstepA;
    const size_t tstep = 2 * hstep;
    const unsigned ldsw = (unsigned)wid * 1024u;
    const int aoff = lds_byte(wr * 64 + fr, fq * 8), boff = lds_byte(wc * 32 + fr, fq * 8);
#define PG8_SA(b, h) (((b) * 2 + (h)) * HTB)
#define PG8_SB(b, h) ((4 + (b) * 2 + (h)) * HTB)
#define PG8_STAGE(bufoff, gbase, voff) do { _Pragma("unroll") for (int _i = 0; _i < 2; ++_i) \
        __builtin_amdgcn_global_load_lds((const unsigned*)((const char*)(gbase) + (voff)[_i]), (PG8_LAS unsigned*)(lds + (bufoff) + ldsw + _i * 8192), 16, 0, 0); } while (0)
#define PG8_LDA(dst, b, h) do { _Pragma("unroll") for (int m = 0; m < 4; ++m) _Pragma("unroll") for (int k = 0; k < 2; ++k) dst[m][k] = *(const PG8_LAS bf16x8*)(lds + PG8_SA(b, h) + aoff + m * 2048 + k * 1024); } while (0)
#define PG8_LDB(dst, b, h) do { _Pragma("unroll") for (int n = 0; n < 2; ++n) _Pragma("unroll") for (int k = 0; k < 2; ++k) dst[n][k] = *(const PG8_LAS bf16x8*)(lds + PG8_SB(b, h) + boff + n * 2048 + k * 1024); } while (0)
#define PG8_MMA(ai, bj, At, Bt) do { __builtin_amdgcn_s_setprio(1); _Pragma("unroll") for (int m = 0; m < 4; ++m) _Pragma("unroll") for (int n = 0; n < 2; ++n) _Pragma("unroll") for (int k = 0; k < 2; ++k) \
        acc[ai][bj][m][n] = __builtin_amdgcn_mfma_f32_16x16x32_bf16(Bt[n][k], At[m][k], acc[ai][bj][m][n], 0, 0, 0); __builtin_amdgcn_s_setprio(0); } while (0)
#define PG8_WAIT_V(n) asm volatile("s_waitcnt vmcnt(" #n ")" ::: "memory")
#define PG8_WAIT_L(n) asm volatile("s_waitcnt lgkmcnt(" #n ")" ::: "memory")
#define PG8_BAR __builtin_amdgcn_s_barrier()
#define PG8_SCHED __builtin_amdgcn_sched_barrier(0)
    Unit cur, nxt; int ui = 0;
    if (!S.next(0, cur)) return;
    f32x4 acc[2][2][4][2];
#pragma unroll
    for (int a = 0; a < 2; ++a)
#pragma unroll
        for (int b = 0; b < 2; ++b)
#pragma unroll
            for (int m = 0; m < 4; ++m)
#pragma unroll
                for (int n = 0; n < 2; ++n) acc[a][b][m][n] = (f32x4){0.f, 0.f, 0.f, 0.f};
    bf16x8 At[4][2], B0[2][2], B1[2][2];
    const char* cA = (const char*)g.A + (size_t)cur.pm * tstepA; const char* cB = (const char*)g.Bt + (size_t)cur.pn * tstep;
    S.a_ready(cur);
    if constexpr (SP2) {
        PG8_STAGE(PG8_SB(0, 0), cB, voffB); PG8_STAGE(PG8_SB(0, 1), cB + hstep, voffB); PG8_STAGE(PG8_SA(0, 0), cA, voffA); PG8_STAGE(PG8_SA(0, 1), cA + hstepA, voffA);
        if (wr == 1) PG8_BAR;
        PG8_WAIT_V(2); PG8_BAR;
        PG8_STAGE(PG8_SB(1, 0), cB + kstep, voffB); PG8_STAGE(PG8_SA(1, 0), cA + kstep, voffA); PG8_STAGE(PG8_SB(1, 1), cB + hstep + kstep, voffB);
        PG8_WAIT_V(6); PG8_BAR;
    } else {
        PG8_STAGE(PG8_SB(0, 0), cB, voffB); PG8_STAGE(PG8_SA(0, 0), cA, voffA); PG8_STAGE(PG8_SB(0, 1), cB + hstep, voffB); PG8_STAGE(PG8_SA(0, 1), cA + hstepA, voffA);
        if (wr == 1) PG8_BAR;
        PG8_WAIT_V(4); PG8_BAR;
        PG8_STAGE(PG8_SB(1, 0), cB + kstep, voffB); PG8_STAGE(PG8_SA(1, 0), cA + kstep, voffA); PG8_STAGE(PG8_SB(1, 1), cB + hstep + kstep, voffB);
        PG8_WAIT_V(6); PG8_BAR;
    }
    for (;;) {
        const bool has_next = S.next(ui + 1, nxt);
        const char* nA = has_next ? (const char*)g.A + (size_t)nxt.pm * tstepA : cA; const char* nB = has_next ? (const char*)g.Bt + (size_t)nxt.pn * tstep : cB;
        for (int t = 0; t < nt; t += 2) {
            const bool last = (t == nt - 2);
            const char* a1 = cA + (size_t)(t + 1) * kstep;
            const char* a2 = last ? nA : cA + (size_t)(t + 2) * kstep; const char* b2 = last ? nB : cB + (size_t)(t + 2) * kstep;
            const char* a3 = a2 + kstep; const char* b3 = b2 + kstep;
            if (last && has_next) S.a_ready(nxt);
            if constexpr (SP2) {
            PG8_LDB(B0, 0, 0); PG8_LDB(B1, 0, 1); PG8_SCHED; PG8_LDA(At, 0, 0); PG8_STAGE(PG8_SA(1, 1), a1 + hstepA, voffA);
            PG8_WAIT_V(8); PG8_WAIT_L(0); PG8_BAR; PG8_MMA(0, 0, At, B0); PG8_MMA(0, 1, At, B1); PG8_BAR; PG8_SCHED;
            PG8_LDA(At, 0, 1); PG8_STAGE(PG8_SB(0, 0), b2, voffB); PG8_STAGE(PG8_SB(0, 1), b2 + hstep, voffB); PG8_STAGE(PG8_SA(0, 0), a2, voffA);
            PG8_WAIT_V(8); PG8_WAIT_L(0); PG8_BAR; PG8_MMA(1, 0, At, B0); PG8_MMA(1, 1, At, B1); PG8_BAR; PG8_SCHED;
            PG8_LDB(B0, 1, 0); PG8_LDB(B1, 1, 1); PG8_SCHED; PG8_LDA(At, 1, 0); PG8_STAGE(PG8_SA(0, 1), a2 + hstepA, voffA);
            PG8_WAIT_V(8); PG8_WAIT_L(0); PG8_BAR; PG8_MMA(0, 0, At, B0); PG8_MMA(0, 1, At, B1); PG8_BAR; PG8_SCHED;
            PG8_LDA(At, 1, 1); PG8_STAGE(PG8_SB(1, 0), b3, voffB); PG8_STAGE(PG8_SB(1, 1), b3 + hstep, voffB); PG8_STAGE(PG8_SA(1, 0), a3, voffA);
            PG8_WAIT_V(8); PG8_WAIT_L(0); PG8_BAR; PG8_MMA(1, 0, At, B0); PG8_MMA(1, 1, At, B1); PG8_BAR; PG8_SCHED;
            } else {
            PG8_LDB(B0, 0, 0); PG8_SCHED; PG8_LDA(At, 0, 0); PG8_STAGE(PG8_SA(1, 1), a1 + hstepA, voffA);
            PG8_WAIT_L(8); PG8_BAR; PG8_WAIT_L(0); PG8_MMA(0, 0, At, B0); PG8_BAR; PG8_SCHED;
            PG8_LDB(B1, 0, 1); PG8_STAGE(PG8_SB(0, 0), b2, voffB);
            PG8_BAR; PG8_WAIT_L(0); PG8_MMA(0, 1, At, B1); PG8_BAR;
            PG8_LDA(At, 0, 1); PG8_STAGE(PG8_SA(0, 0), a2, voffA);
            PG8_BAR; PG8_WAIT_L(0); PG8_MMA(1, 0, At, B0); PG8_BAR; PG8_SCHED;
            PG8_STAGE(PG8_SB(0, 1), b2 + hstep, voffB);
            PG8_WAIT_V(6); PG8_BAR; PG8_MMA(1, 1, At, B1); PG8_BAR;
            PG8_LDB(B0, 1, 0); PG8_SCHED; PG8_LDA(At, 1, 0); PG8_STAGE(PG8_SA(0, 1), a2 + hstepA, voffA);
            PG8_WAIT_L(8); PG8_BAR; PG8_WAIT_L(0); PG8_MMA(0, 0, At, B0); PG8_BAR; PG8_SCHED;
            PG8_LDB(B1, 1, 1); PG8_STAGE(PG8_SB(1, 0), b3, voffB);
            PG8_BAR; PG8_WAIT_L(0); PG8_MMA(0, 1, At, B1); PG8_BAR;
            PG8_LDA(At, 1, 1); PG8_STAGE(PG8_SA(1, 0), a3, voffA);
            PG8_BAR; PG8_WAIT_L(0); PG8_MMA(1, 0, At, B0); PG8_BAR; PG8_SCHED;
            PG8_STAGE(PG8_SB(1, 1), b3 + hstep, voffB);
            PG8_WAIT_V(6); PG8_BAR; PG8_MMA(1, 1, At, B1); PG8_BAR;
            }
        }
        if constexpr (ALIGN_EPI) { if (wr == 0) PG8_BAR; }
        if constexpr (!Epi::AFTER_DRAIN) { E(acc, cur, wr, wc, fr, fq); S.done(cur); }
        if (!has_next) break;
#pragma unroll
        for (int a = 0; a < 2; ++a)
#pragma unroll
            for (int b = 0; b < 2; ++b)
#pragma unroll
                for (int m = 0; m < 4; ++m)
#pragma unroll
                    for (int n = 0; n < 2; ++n) acc[a][b][m][n] = (f32x4){0.f, 0.f, 0.f, 0.f};
        cur = nxt; cA = nA; cB = nB; ++ui;
        if constexpr (ALIGN_EPI) { if (wr == 1) PG8_BAR; }
    }
    PG8_WAIT_V(0);
    if constexpr (!ALIGN_EPI) { if (wr == 0) PG8_BAR; }
    PG8_BAR;
    if constexpr (Epi::AFTER_DRAIN) { E.fused(acc, cur, wr, wc, fr, fq, lds, wid, lane); S.done(cur); }
#undef PG8_SA
#undef PG8_SB
#undef PG8_STAGE
#undef PG8_LDA
#undef PG8_LDB
#undef PG8_MMA
#undef PG8_WAIT_V
#undef PG8_WAIT_L
#undef PG8_BAR
#undef PG8_SCHED
}
}
namespace att {
typedef unsigned short bf16;
typedef short bf16x8 __attribute__((ext_vector_type(8)));
typedef short s16x4 __attribute__((ext_vector_type(4)));
typedef float f32x16 __attribute__((ext_vector_type(16)));
typedef float f32x4 __attribute__((ext_vector_type(4)));
typedef unsigned u32x4 __attribute__((ext_vector_type(4)));
constexpr int D = 128, NW = 8, QBLK = 32, KVBLK = 64, QB = NW * QBLK;
constexpr int SHM_V = KVBLK * D * 2, SHM_K = KVBLK * D * 2;
constexpr int LDS_WS = 3 * SHM_V + 3 * SHM_K, LDS_LUT = LDS_WS + NW * 64 * 4, LDS_BYTES = LDS_LUT + 32 * 128 * 4;
constexpr float THR = 8.f;
#define KSWZ(row, colB) ((row) * 256 + ((colB) ^ (((row) & 7) << 4)))
#define SBAR() __builtin_amdgcn_sched_barrier(0)
__device__ __forceinline__ int v_st(int k, int c) { const int kk = (k & ~0xC) | ((k & 4) << 1) | ((k & 8) >> 1); return ((kk >> 3) * 4 + (c >> 5)) * 512 + ((kk & 7) * 32 + (c & 31)) * 2; }
__device__ __forceinline__ int v_rd_base(int lane) { return ((lane & 3) << 3) | (((lane >> 2) & 3) << 6) | (((lane >> 4) & 1) << 5) | (((lane >> 5) & 1) << 8); }
constexpr int v_rd_off(int d0, int ks, int half) { return d0 * 512 + ks * 4096 + half * 2048; }
__device__ __forceinline__ int crow(int r, int hi) { return (r & 3) + 8 * (r >> 2) + 4 * hi; }
__device__ __forceinline__ unsigned cvtpk(float lo, float hi) { unsigned r; asm volatile("v_cvt_pk_bf16_f32 %0, %1, %2" : "=v"(r) : "v"(lo), "v"(hi)); return r; }
__device__ __forceinline__ bf16x8 load8(const bf16* p) { return *reinterpret_cast<const bf16x8*>(p); }
__device__ __forceinline__ void bias_mask_tile(f32x16& p0, f32x16& p1, int dq, unsigned W, const float* lut) {
    const float NEG = -__builtin_inff();
#pragma unroll
    for (int r = 0; r < 16; ++r) {
        const int c = (r & 3) + 8 * (r >> 2);
        const int d0 = dq - c, d1 = dq - c - 32;
        const int i0 = d0 < 0 ? 0 : (d0 > 127 ? 127 : d0), i1 = d1 < 0 ? 0 : (d1 > 127 ? 127 : d1);
        const float b0 = lut[i0], b1 = lut[i1];
        p0[r] = ((unsigned)d0 >= W) ? NEG : p0[r] + b0;
        p1[r] = ((unsigned)d1 >= W) ? NEG : p1[r] + b1;
    }
}
__device__ __forceinline__ void partialSM(f32x16& p0, f32x16& p1, float& m_reg, float& mn, float& alpha) {
    float pmax = p0[0];
#pragma unroll
    for (int r = 1; r < 16; ++r) pmax = fmaxf(pmax, p0[r]);
#pragma unroll
    for (int r = 0; r < 16; ++r) pmax = fmaxf(pmax, p1[r]);
    { auto rr = __builtin_amdgcn_permlane32_swap(__float_as_uint(pmax), __float_as_uint(pmax), false, false);
      pmax = fmaxf(__uint_as_float(rr[0]), __uint_as_float(rr[1])); }
    if (__builtin_expect(__all((pmax - m_reg) <= THR), 1)) { mn = m_reg; alpha = 1.f; }
    else { mn = fmaxf(m_reg, pmax); alpha = __builtin_amdgcn_exp2f(m_reg - mn); m_reg = mn; }
#pragma unroll
    for (int r = 0; r < 16; ++r) p0[r] = p0[r] - mn;
#pragma unroll
    for (int r = 0; r < 16; ++r) p1[r] = p1[r] - mn;
#pragma unroll
    for (int r = 0; r < 16; ++r) p0[r] = __builtin_amdgcn_exp2f(p0[r]);
}
__device__ __forceinline__ void finishSM(f32x16& p0, f32x16& p1, float alpha, float& l_reg, bf16x8& pa0, bf16x8& pa1, bf16x8& pa2, bf16x8& pa3) {
#pragma unroll
    for (int r = 0; r < 16; ++r) p1[r] = __builtin_amdgcn_exp2f(p1[r]);
    float ps = 0;
#pragma unroll
    for (int r = 0; r < 16; ++r) ps += p0[r];
#pragma unroll
    for (int r = 0; r < 16; ++r) ps += p1[r];
    { auto rr = __builtin_amdgcn_permlane32_swap(__float_as_uint(ps), __float_as_uint(ps), false, false);
      ps = __uint_as_float(rr[0]) + __uint_as_float(rr[1]); }
    l_reg = l_reg * alpha + ps;
#define PK4(P, B_, OUT) do { unsigned a0 = cvtpk(P[B_+0], P[B_+1]), a1 = cvtpk(P[B_+2], P[B_+3]);                          \
        unsigned b0 = cvtpk(P[B_+4], P[B_+5]), b1 = cvtpk(P[B_+6], P[B_+7]);                                             \
        auto r0 = __builtin_amdgcn_permlane32_swap(a0, b0, false, false); auto r1 = __builtin_amdgcn_permlane32_swap(a1, b1, false, false); \
        u32x4 w = {r0[0], r1[0], r0[1], r1[1]}; OUT = *reinterpret_cast<bf16x8*>(&w); } while (0)
    PK4(p0, 0, pa0); PK4(p0, 8, pa1); PK4(p1, 0, pa2); PK4(p1, 8, pa3);
#undef PK4
}
template <bool SK>
__device__ __forceinline__ void qkt(f32x16& p0, f32x16& p1, const char* K_lds, int r32, int hi, const bf16x8* qr, bool act, float binit) {
    if (SK && !act) { const float NEG = -__builtin_inff();
#pragma unroll
        for (int r = 0; r < 16; ++r) { p0[r] = NEG; p1[r] = NEG; } return; }
#pragma unroll
    for (int r = 0; r < 16; ++r) { p0[r] = binit; p1[r] = binit; }
    const char* kb[4];
#pragma unroll
    for (int dd = 0; dd < 4; ++dd) kb[dd] = K_lds + KSWZ(r32, (dd * 16 + hi * 8) * 2);
#pragma unroll
    for (int d0 = 0; d0 < 8; ++d0) { const char* a = kb[d0 & 3] + (d0 >> 2) * 128;
        bf16x8 b0 = *reinterpret_cast<const bf16x8*>(a);
        bf16x8 b1 = *reinterpret_cast<const bf16x8*>(a + 32 * 256);
        p0 = __builtin_amdgcn_mfma_f32_32x32x16_bf16(b0, qr[d0], p0, 0, 0, 0);
        p1 = __builtin_amdgcn_mfma_f32_32x32x16_bf16(b1, qr[d0], p1, 0, 0, 0); }
}
template <bool SK>
__device__ __forceinline__ void pv_tile(f32x16* o, int vb0, bf16x8 pa0, bf16x8 pa1, bf16x8 pa2, bf16x8 pa3, bool act) {
    if (SK && !act) return;
#define TRRD(dst, off) asm volatile("ds_read_b64_tr_b16 %0, %1 offset:%2" : "=&v"(dst) : "v"(vb0), "i"(off) : "memory")
#define PV_D0(d0) do { s16x4 l0, l1, l2, l3, h0, h1, h2, h3; constexpr int b_ = v_rd_off(d0, 0, 0); \
        TRRD(l0, b_); TRRD(h0, b_ + 2048); TRRD(l1, b_ + 4096); TRRD(h1, b_ + 6144); TRRD(l2, b_ + 8192); TRRD(h2, b_ + 10240); TRRD(l3, b_ + 12288); TRRD(h3, b_ + 14336); \
        asm volatile("s_waitcnt lgkmcnt(0)" ::: "memory"); SBAR();   \
        o[d0] = __builtin_amdgcn_mfma_f32_32x32x16_bf16(pa0, (bf16x8){l0[0], l0[1], l0[2], l0[3], h0[0], h0[1], h0[2], h0[3]}, o[d0], 0, 0, 0);   \
        o[d0] = __builtin_amdgcn_mfma_f32_32x32x16_bf16(pa1, (bf16x8){l1[0], l1[1], l1[2], l1[3], h1[0], h1[1], h1[2], h1[3]}, o[d0], 0, 0, 0);   \
        o[d0] = __builtin_amdgcn_mfma_f32_32x32x16_bf16(pa2, (bf16x8){l2[0], l2[1], l2[2], l2[3], h2[0], h2[1], h2[2], h2[3]}, o[d0], 0, 0, 0);   \
        o[d0] = __builtin_amdgcn_mfma_f32_32x32x16_bf16(pa3, (bf16x8){l3[0], l3[1], l3[2], l3[3], h3[0], h3[1], h3[2], h3[3]}, o[d0], 0, 0, 0); } while (0)
    PV_D0(0); PV_D0(1); PV_D0(2); PV_D0(3);
#undef PV_D0
#undef TRRD
}
struct BlockRef { const bf16* Q; const bf16* K; const bf16* V; bf16* O; int P0; int map; float sink2; };
struct Seam { bf16x8 qr[8]; int slot; };
struct Stg { unsigned k0, k1, v0, v1; };
__device__ __forceinline__ int swa_jlo(int P0, int W) { const int lowk = P0 - W + 1; return lowk > 0 ? lowk / KVBLK : 0; }
#define LASU __attribute__((address_space(3))) unsigned
#define VMW() asm volatile("s_waitcnt vmcnt(0)" ::: "memory")
#define VMWN(n) asm volatile("s_waitcnt vmcnt(%0)" :: "i"(n) : "memory")
template <int LDQK>
__device__ __forceinline__ Stg make_stg(int wid, int lane) {
    Stg g;
    { const int s = wid * 2, row = s * 4 + (lane >> 4), cc = lane & 15; g.k0 = (unsigned)(row * LDQK + ((cc ^ (row & 7)) * 8)) * 2u; }
    { const int s = wid * 2 + 1, row = s * 4 + (lane >> 4), cc = lane & 15; g.k1 = (unsigned)(row * LDQK + ((cc ^ (row & 7)) * 8)) * 2u; }
    { const int s = wid * 2, kk = (s >> 1) * 8 + ((lane >> 2) & 7), c = ((s & 1) * 2 + (lane >> 5)) * 32 + (lane & 3) * 8, k = (kk & ~0xC) | ((kk & 4) << 1) | ((kk & 8) >> 1); g.v0 = (unsigned)(k * LDQK + c) * 2u; }
    { const int s = wid * 2 + 1, kk = (s >> 1) * 8 + ((lane >> 2) & 7), c = ((s & 1) * 2 + (lane >> 5)) * 32 + (lane & 3) * 8, k = (kk & ~0xC) | ((kk & 4) << 1) | ((kk & 8) >> 1); g.v1 = (unsigned)(k * LDQK + c) * 2u; }
    return g;
}
template <int LDQK>
__device__ __forceinline__ void dma_tile(const bf16* Kh, const bf16* Vh, int kbase, int slot, char* lds, int wid, const Stg& g) {
    const char* kt = (const char*)(Kh + (size_t)kbase * LDQK); const char* vt = (const char*)(Vh + (size_t)kbase * LDQK);
    char* kd = lds + 3 * SHM_V + slot * SHM_K + wid * 2048; char* vd = lds + slot * SHM_V + wid * 2048;
    __builtin_amdgcn_global_load_lds((const unsigned*)(kt + g.k0), (LASU*)kd, 16, 0, 0);
    __builtin_amdgcn_global_load_lds((const unsigned*)(kt + g.k1), (LASU*)(kd + 1024), 16, 0, 0);
    __builtin_amdgcn_global_load_lds((const unsigned*)(vt + g.v0), (LASU*)vd, 16, 0, 0);
    __builtin_amdgcn_global_load_lds((const unsigned*)(vt + g.v1), (LASU*)(vd + 1024), 16, 0, 0);
}
template <int LDQK>
__device__ __forceinline__ void attn_prime(const BlockRef& cur, int W, char* lds, Seam& S, const Stg& g, int tid) {
    const int wid = __builtin_amdgcn_readfirstlane(tid >> 6), lane = tid & 63, r32 = lane & 31, hi = lane >> 5;
    S.slot = 0;
    dma_tile<LDQK>(cur.K, cur.V, swa_jlo(cur.P0, W) * KVBLK, 0, lds, wid, g);
#pragma unroll
    for (int d0 = 0; d0 < 8; ++d0) S.qr[d0] = load8(cur.Q + (size_t)(wid * QBLK + r32) * LDQK + d0 * 16 + hi * 8);
    VMW(); __syncthreads();
}
template <int LDQK, int LDO>
__device__ __forceinline__ void attn_block(const BlockRef& cur, const BlockRef& nxt, int skv, int W, char* lds, Seam& S, const Stg& g, int tid) {
    constexpr bool SK = false;
    const int wid = __builtin_amdgcn_readfirstlane(tid >> 6), lane = tid & 63, r32 = lane & 31, hi = lane >> 5;
    const int j_lo = swa_jlo(cur.P0, W);
    int j_hi = (cur.P0 + QB - 1) / KVBLK + 1; if (j_hi > skv / KVBLK) j_hi = skv / KVBLK;
    const int NT = j_hi - j_lo;
    const int kbn = swa_jlo(nxt.P0, W) * KVBLK;
    const int qlo = cur.P0 + wid * QBLK, qm = qlo + r32 - 4 * hi;
    char* V_lds = lds; char* K_lds = lds + 3 * SHM_V;
    float* ws = (float*)(lds + LDS_WS) + wid * 64; float* li_l = ws, * al_l = ws + 32;
    const float* lut = (const float*)(lds + LDS_LUT) + cur.map * 128;
    const float cfar = __builtin_bit_cast(float, __builtin_amdgcn_readfirstlane(__builtin_bit_cast(int, lut[127])));
    float m_reg = -1e30f, l_reg = 0; f32x16 o[4] = {};
    const int vb0 = (int)(uintptr_t)V_lds + v_rd_base(lane);
    const bf16* Kh = cur.K; const bf16* Vh = cur.V;
    int sl = S.slot;
#define NEXT(s) ((s) == 2 ? 0 : (s) + 1)
#define PREV(s) ((s) == 0 ? 2 : (s) - 1)
#define RESC(a) do { if (__any((a) < 1.f)) { if (hi == 0) al_l[r32] = (a); asm volatile("s_waitcnt lgkmcnt(0)" ::: "memory");              \
                     for (int d_ = 0; d_ < 4; ++d_) for (int r = 0; r < 16; ++r) o[d_][r] *= al_l[crow(r, hi)]; } } while (0)
#define KBASE(t) ((j_lo + (t)) * KVBLK)
#define ACT(t) (KBASE(t) <= qlo + QBLK - 1 && KBASE(t) + KVBLK - 1 >= qlo - W + 1)
#define FIX(t) (KBASE(t) + KVBLK + 126 > qlo || KBASE(t) <= qlo + QBLK - 1 - W)
#define BINIT(t) (FIX(t) ? 0.f : cfar)
#define MASKT(P0_, P1_, t) do { const int kb_ = KBASE(t); if ((!SK || ACT(t)) && FIX(t)) bias_mask_tile(P0_, P1_, qm - kb_, (unsigned)W, lut); } while (0)
    f32x16 pA0, pA1, pB0, pB1; float mnA, mnB, alA, alB; bf16x8 pa0, pa1, pa2, pa3;
    if (NT > 1) dma_tile<LDQK>(Kh, Vh, KBASE(1), NEXT(sl), lds, wid, g);
    SBAR(); qkt<SK>(pA0, pA1, K_lds + sl * SHM_K, r32, hi, S.qr, ACT(0), BINIT(0));
    MASKT(pA0, pA1, 0); partialSM(pA0, pA1, m_reg, mnA, alA);
    VMW(); __syncthreads();
    sl = NEXT(sl);
#define HALF_STEP(PX0, PX1, mnX, alX, PY0, PY1, alY, t) do {                                                                  \
        if ((t) + 1 < NT) dma_tile<LDQK>(Kh, Vh, KBASE((t) + 1), NEXT(sl), lds, wid, g);                                      \
        SBAR(); qkt<SK>(PX0, PX1, K_lds + sl * SHM_K, r32, hi, S.qr, ACT(t), BINIT(t));                                       \
        finishSM(PY0, PY1, alY, l_reg, pa0, pa1, pa2, pa3); SBAR();                                                           \
        pv_tile<SK>(o, vb0 + PREV(sl) * SHM_V, pa0, pa1, pa2, pa3, ACT((t) - 1)); MASKT(PX0, PX1, (t)); partialSM(PX0, PX1, m_reg, mnX, alX); \
        VMW(); __syncthreads();                                                                                               \
        RESC(alX); sl = NEXT(sl); } while (0)
    int t = 1;
    for (; t + 1 < NT; t += 2) {
        HALF_STEP(pB0, pB1, mnB, alB, pA0, pA1, alA, t);
        HALF_STEP(pA0, pA1, mnA, alA, pB0, pB1, alB, t + 1);
    }
    const bool even = (NT & 1) == 0;
    if (even) { SBAR(); qkt<SK>(pB0, pB1, K_lds + sl * SHM_K, r32, hi, S.qr, ACT(NT - 1), BINIT(NT - 1)); SBAR(); sl = NEXT(sl); }
    dma_tile<LDQK>(nxt.K, nxt.V, kbn, sl, lds, wid, g); SBAR();
#pragma unroll
    for (int d0 = 0; d0 < 8; ++d0) S.qr[d0] = load8(nxt.Q + (size_t)(wid * QBLK + r32) * LDQK + d0 * 16 + hi * 8);
    SBAR();
    S.slot = sl;
    finishSM(pA0, pA1, alA, l_reg, pa0, pa1, pa2, pa3); SBAR();
    pv_tile<SK>(o, vb0 + (even ? PREV(PREV(sl)) : PREV(sl)) * SHM_V, pa0, pa1, pa2, pa3, ACT(even ? NT - 2 : NT - 1));
    if (even) { MASKT(pB0, pB1, NT - 1); partialSM(pB0, pB1, m_reg, mnB, alB); RESC(alB);
        finishSM(pB0, pB1, alB, l_reg, pa0, pa1, pa2, pa3); SBAR(); pv_tile<SK>(o, vb0 + PREV(sl) * SHM_V, pa0, pa1, pa2, pa3, ACT(NT - 1)); }
    SBAR(); VMWN(8); SBAR();
    if (hi == 0) li_l[r32] = l_reg + __builtin_amdgcn_exp2f(cur.sink2 - m_reg);
    asm volatile("s_waitcnt lgkmcnt(0)" ::: "memory");
    float rli[16];
#pragma unroll
    for (int r = 0; r < 16; ++r) rli[r] = __builtin_amdgcn_rcpf(li_l[crow(r, hi)]);
    bf16* Ow = cur.O + (size_t)(wid * QBLK) * LDO;
#pragma unroll
    for (int r = 0; r < 16; ++r) { const int orow = crow(r, hi);
#pragma unroll
        for (int d0 = 0; d0 < 4; ++d0) { const float v = o[d0][r] * rli[r];
            const float vn = __shfl_xor(v, 1);
            if ((r32 & 1) == 0) *(unsigned*)(Ow + (size_t)orow * LDO + d0 * 32 + r32) = cvtpk(v, vn); } }
    __syncthreads();
#undef RESC
#undef KBASE
#undef ACT
#undef FIX
#undef BINIT
#undef MASKT
#undef HALF_STEP
#undef NEXT
#undef PREV
}
#undef VMW
#undef VMWN
#undef LASU
}
constexpr int NWAVES = 8;
constexpr int BATCH = 2, SEQ = 8192, DM = 4096, M = BATCH * SEQ;
constexpr int DFF = 11008, NQKV = 3 * DM, NGU = 2 * DFF, NKVQ = 2048 + DM;
constexpr float EPS = 1e-6f, LOG2E = 1.4426950408889634f, QSCALE = 0.08838834764831845f * LOG2E;
constexpr float LAMBDA_INIT = 0.2f;
__device__ const unsigned char T5_BUCKET[128] = {0, 1, 2, 3, 4, 5, 6, 7, 8, 9, 10, 11, 12, 13, 14, 15, 16, 16, 16, 17, 17, 18, 18, 18, 19, 19, 19, 20, 20, 20, 20, 21, 21, 21, 21, 22, 22, 22, 22, 22, 23, 23, 23, 23, 23, 23, 24, 24, 24, 24, 24, 24, 25, 25, 25, 25, 25, 25, 25, 26, 26, 26, 26, 26, 26, 26, 26, 27, 27, 27, 27, 27, 27, 27, 27, 27, 27, 28, 28, 28, 28, 28, 28, 28, 28, 28, 28, 29, 29, 29, 29, 29, 29, 29, 29, 29, 29, 29, 29, 30, 30, 30, 30, 30, 30, 30, 30, 30, 30, 30, 30, 30, 30, 31, 31, 31, 31, 31, 31, 31, 31, 31, 31, 31, 31, 31, 31, 31};
constexpr size_t MiB = 1u << 20;
constexpr size_t WS_CTL = 0, CTL_ZERO_BYTES = 1 * MiB;
constexpr size_t SZ_WQKV = (size_t)NQKV * DM * 2, SZ_WSQ = (size_t)DM * DM * 2, SZ_WGU = (size_t)NGU * DM * 2, SZ_WD = (size_t)DM * DFF * 2, SZ_WKVQ = (size_t)NKVQ * DM * 2;
constexpr size_t WS_WQKV = 1 * MiB, WS_WOA = WS_WQKV + SZ_WQKV, WS_WGU0 = WS_WOA + SZ_WSQ, WS_WD0 = WS_WGU0 + SZ_WGU, WS_WKVQ = WS_WD0 + SZ_WD, WS_WOB = WS_WKVQ + SZ_WKVQ,
                 WS_WGU1 = WS_WOB + SZ_WSQ, WS_WD1 = WS_WGU1 + SZ_WGU, WS_WEND = WS_WD1 + SZ_WD;
constexpr size_t WS_H = WS_WEND;
constexpr size_t WS_R1 = WS_H + (size_t)M * DM * 2;
constexpr size_t WS_R2 = WS_R1 + (size_t)M * NQKV * 2;
constexpr size_t WS_END = WS_R2 + (size_t)M * 8192 * 2;
constexpr int CW_TMO = 0, CW_CODE = 1, CW_BAR = 4096;
constexpr int RING_OFF = 0, RING_BYTES = 131072;
constexpr int LDSCTL_OFF = RING_BYTES, MISC_OFF = LDSCTL_OFF + 320;
constexpr int LDS_BYTES = 147456;
static_assert(att::LDS_BYTES <= RING_BYTES, "attention LDS");
#define GAS __attribute__((address_space(1)))
#define LAS __attribute__((address_space(3)))
typedef unsigned short bf16;
typedef unsigned v4u __attribute__((ext_vector_type(4)));
typedef float f32x4 __attribute__((ext_vector_type(4)));
typedef short bf16x8 __attribute__((ext_vector_type(8)));
typedef GAS unsigned gu32;
typedef GAS unsigned long long gu64;
#define RLX_AGENT __ATOMIC_RELAXED, __HIP_MEMORY_SCOPE_AGENT
#define LDS_WAIT() asm volatile("s_waitcnt lgkmcnt(0)" ::: "memory")
#define VM_WAIT() asm volatile("s_waitcnt vmcnt(0)" ::: "memory")
__device__ __forceinline__ unsigned long long rt() { return __builtin_amdgcn_s_memrealtime(); }
__device__ __forceinline__ unsigned f2bf(float f) { unsigned u = __builtin_bit_cast(unsigned, f); return (u + 0x7fffu + ((u >> 16) & 1u)) >> 16; }
__device__ __forceinline__ unsigned pk2(float lo, float hi) { return f2bf(lo) | (f2bf(hi) << 16); }

#define XB_TMO      128
#define XB_XCNT(j)  (256  + 64 * (j))
#define XB_XSUB(j)  (1280 + 64 * (j))
#define XB_XGEN(j)  (2304 + 64 * (j))
#define XB_TOP      3328
#define XB_TOPGEN   3392
#define XCD_BAR_WORDS 3456
#define XB_SPIN_CAP (1u << 18)

__device__ __forceinline__ unsigned xb_ld(unsigned* p)              { return __hip_atomic_load(p, __ATOMIC_RELAXED, __HIP_MEMORY_SCOPE_AGENT); }
__device__ __forceinline__ unsigned xb_add(unsigned* p, unsigned v) { return __hip_atomic_fetch_add(p, v, __ATOMIC_RELAXED, __HIP_MEMORY_SCOPE_AGENT); }
__device__ __forceinline__ unsigned xb_xcc_id() { return (unsigned)__builtin_amdgcn_s_getreg((3 << 11) | 20) & 0xFu; }
#define XB_SPIN(cond, bar) do { unsigned _sp = 0; while (cond) { __builtin_amdgcn_s_sleep(1); \
    if ((++_sp & 255u) == 0u) { if (xb_ld(&(bar)[XB_TMO])) break; if (_sp > XB_SPIN_CAP) { atomicAdd(&(bar)[XB_TMO], 1u); break; } } } } while (0)

struct XcdBarrier {
    unsigned* bar; unsigned x;
    volatile LAS unsigned* st;
};

__device__ __forceinline__ XcdBarrier xcd_barrier_post(unsigned* bar, volatile LAS unsigned* st) {
    XcdBarrier b; b.bar = bar; b.x = xb_xcc_id(); b.st = st;
    if (threadIdx.x == 0) (void)xb_add(&bar[XB_XCNT(b.x)], 1u);
    return b;
}
__device__ __forceinline__ void xcd_barrier_complete(unsigned* bar, unsigned x, unsigned& nloc, unsigned& nx) {
    const unsigned G = gridDim.x * gridDim.y * gridDim.z;
    unsigned sum, cnt, mine, sp = 0u;
    for (;;) {
        sum = 0u; cnt = 0u; mine = 0u;
#pragma unroll
        for (unsigned j = 0; j < 16; ++j) { const unsigned c = xb_ld(&bar[XB_XCNT(j)]); sum += c; cnt += (c > 0u) ? 1u : 0u; }
        mine = xb_ld(&bar[XB_XCNT(x)]);
        if (sum == G) break;
        __builtin_amdgcn_s_sleep(1);
        if ((++sp & 255u) == 0u) { if (xb_ld(&bar[XB_TMO])) break; if (sp > XB_SPIN_CAP) { atomicAdd(&bar[XB_TMO], 1u); break; } }
    }
    nloc = mine > 0u ? mine : 1u; nx = cnt > 0u ? cnt : 1u;
}

__device__ __forceinline__ void xcd_barrier(const XcdBarrier& b) {
    asm volatile("s_waitcnt vmcnt(0)" ::: "memory");
    __syncthreads();
    if (threadIdx.x == 0) {
        unsigned* bar = b.bar; asm volatile("" : "+s"(bar));
        __builtin_amdgcn_s_waitcnt(0);
        unsigned nloc = b.st[0], nx = b.st[1];
        if (nloc == 0u) { xcd_barrier_complete(bar, b.x, nloc, nx); b.st[0] = nloc; b.st[1] = nx; }
        const unsigned old = xb_add(&bar[XB_XSUB(b.x)], 1u);
        const unsigned gen = old / nloc;
        if (old + 1u == (gen + 1u) * nloc) {
            __builtin_amdgcn_fence(__ATOMIC_RELEASE, "agent");
            asm volatile("s_waitcnt vmcnt(0)" ::: "memory");
            const unsigned og = xb_add(&bar[XB_TOP], 1u);
            const unsigned tg = og / nx;
            if (og + 1u == (tg + 1u) * nx) xb_add(&bar[XB_TOPGEN], 1u);
            else XB_SPIN(xb_ld(&bar[XB_TOPGEN]) == tg, bar);
            __builtin_amdgcn_fence(__ATOMIC_ACQUIRE, "agent");
            xb_add(&bar[XB_XGEN(b.x)], 1u);
            asm volatile("s_waitcnt vmcnt(0)" ::: "memory");
        } else {
            XB_SPIN(xb_ld(&bar[XB_XGEN(b.x)]) == gen, bar);
            __builtin_amdgcn_fence(__ATOMIC_ACQUIRE, "agent");
            asm volatile("s_waitcnt vmcnt(0)" ::: "memory");
        }
    }
    __syncthreads();
}
struct Args { const float* in[20]; float* out; unsigned char* ws; };
struct Frame {
    LAS unsigned char* lds; volatile LAS unsigned* MISC; gu32* ctl;
    int tid, lane, wave, vcu, G;
};
__device__ __forceinline__ float wave_sum(float v) {
#pragma unroll
    for (int o = 1; o < 64; o <<= 1) v += __shfl_xor(v, o);
    return v;
}
__device__ __forceinline__ void transpose_item(const float* W, int K, int N, bf16* WT, int drow0, const float* gain, LAS float* scr, int k0, int n0, int lane) {
#pragma unroll 8
    for (int i = 0; i < 32; ++i) { const int kk = 2 * i + (lane >> 5); float w = W[(size_t)(k0 + kk) * N + n0 + (lane & 31)]; if (gain) w *= gain[k0 + kk]; scr[kk * 33 + (lane & 31)] = w; }
    LDS_WAIT(); asm volatile("" ::: "memory");
    const int c = lane & 7;
#pragma unroll
    for (int j = 0; j < 4; ++j) { const int n = (lane >> 3) + 8 * j; const LAS float* s = scr + (8 * c) * 33 + n;
        v4u o; o.x = pk2(s[0 * 33], s[1 * 33]); o.y = pk2(s[2 * 33], s[3 * 33]); o.z = pk2(s[4 * 33], s[5 * 33]); o.w = pk2(s[6 * 33], s[7 * 33]);
        *(GAS v4u*)(WT + (size_t)(drow0 + n) * K + k0 + 8 * c) = o; }
    LDS_WAIT(); asm volatile("" ::: "memory");
}
__device__ __forceinline__ void rms_rows(Frame& F, const float* X, bf16* H) {
    const int gw = F.vcu * NWAVES + F.wave, NGW = F.G * NWAVES;
    for (int m = gw; m < M; m += NGW) {
        const GAS f32x4* xr = (const GAS f32x4*)(X + (size_t)m * DM) + F.lane;
        f32x4 v[16]; float s = 0.f;
#pragma unroll
        for (int j = 0; j < 16; ++j) { v[j] = xr[64 * j]; s += (v[j].x * v[j].x + v[j].y * v[j].y) + (v[j].z * v[j].z + v[j].w * v[j].w); }
        const float rstd = 1.0f / sqrtf(wave_sum(s) * (1.f / DM) + EPS);
        GAS unsigned long long* o8 = (GAS unsigned long long*)(H + (size_t)m * DM) + F.lane;
#pragma unroll
        for (int j = 0; j < 16; ++j) o8[64 * j] = (unsigned long long)pk2(v[j].x * rstd, v[j].y * rstd) | ((unsigned long long)pk2(v[j].z * rstd, v[j].w * rstd) << 32);
    }
}
__device__ __forceinline__ void head_norm(Frame& F, bf16* T, int ld, int nchunk, int nA, int colA, int colB, const float* gA, float sA, const float* gB, float sB) {
    const int gw = F.vcu * NWAVES + F.wave, NGW = F.G * NWAVES;
    const int d0 = (F.lane & 15) * 8;
    float ga[8], gb[8];
#pragma unroll
    for (int e = 0; e < 8; ++e) { ga[e] = gA[d0 + e] * sA; gb[e] = gB[d0 + e] * sB; }
    const int total = M * nchunk;
    for (int it = gw; it < total; it += NGW) {
        const int m = it / nchunk, c = it - m * nchunk;
        const bool isA = c < nA;
        const int col = (isA ? colA + 512 * c : colB + 512 * (c - nA)) + F.lane * 8;
        GAS v4u* p = (GAS v4u*)(T + (size_t)m * ld + col);
        const v4u w = *p;
        float x[8];
        x[0] = __uint_as_float(w.x << 16); x[1] = __uint_as_float(w.x & 0xffff0000u); x[2] = __uint_as_float(w.y << 16); x[3] = __uint_as_float(w.y & 0xffff0000u);
        x[4] = __uint_as_float(w.z << 16); x[5] = __uint_as_float(w.z & 0xffff0000u); x[6] = __uint_as_float(w.w << 16); x[7] = __uint_as_float(w.w & 0xffff0000u);
        float s = 0.f;
#pragma unroll
        for (int e = 0; e < 8; ++e) s += x[e] * x[e];
        s += __shfl_xor(s, 1); s += __shfl_xor(s, 2); s += __shfl_xor(s, 4); s += __shfl_xor(s, 8);
        const float rstd = 1.0f / sqrtf(s * (1.f / 128.f) + EPS);
#pragma unroll
        for (int e = 0; e < 8; ++e) x[e] = x[e] * rstd * (isA ? ga[e] : gb[e]);
        v4u o; o.x = pk2(x[0], x[1]); o.y = pk2(x[2], x[3]); o.z = pk2(x[4], x[5]); o.w = pk2(x[6], x[7]);
        *p = o;
    }
}
__device__ __forceinline__ void diff_combine(Frame& F, const bf16* O2, bf16* Oc, const float* lam_qk, const float* g_sub) {
    const int gw = F.vcu * NWAVES + F.wave, NGW = F.G * NWAVES;
    float s1 = lam_qk[F.lane] * lam_qk[128 + F.lane] + lam_qk[64 + F.lane] * lam_qk[192 + F.lane];
    float s2 = lam_qk[256 + F.lane] * lam_qk[384 + F.lane] + lam_qk[320 + F.lane] * lam_qk[448 + F.lane];
    s1 = wave_sum(s1); s2 = wave_sum(s2);
    const float lam = expf(s1) - expf(s2) + LAMBDA_INIT;
    const int e0 = (F.lane & 31) * 8;
    float gs[8];
#pragma unroll
    for (int e = 0; e < 8; ++e) gs[e] = g_sub[e0 + e] * (1.0f - LAMBDA_INIT);
    const int total = M * 8;
    for (int it = gw; it < total; it += NGW) {
        const int m = it >> 3, h = (it & 7) * 2 + (F.lane >> 5);
        const GAS v4u* p1 = (const GAS v4u*)(O2 + (size_t)m * 8192 + (2 * h) * 256 + e0);
        const v4u a = p1[0], b = p1[32];
        float x[8], y[8];
        x[0] = __uint_as_float(a.x << 16); x[1] = __uint_as_float(a.x & 0xffff0000u); x[2] = __uint_as_float(a.y << 16); x[3] = __uint_as_float(a.y & 0xffff0000u);
        x[4] = __uint_as_float(a.z << 16); x[5] = __uint_as_float(a.z & 0xffff0000u); x[6] = __uint_as_float(a.w << 16); x[7] = __uint_as_float(a.w & 0xffff0000u);
        y[0] = __uint_as_float(b.x << 16); y[1] = __uint_as_float(b.x & 0xffff0000u); y[2] = __uint_as_float(b.y << 16); y[3] = __uint_as_float(b.y & 0xffff0000u);
        y[4] = __uint_as_float(b.z << 16); y[5] = __uint_as_float(b.z & 0xffff0000u); y[6] = __uint_as_float(b.w << 16); y[7] = __uint_as_float(b.w & 0xffff0000u);
        float s = 0.f;
#pragma unroll
        for (int e = 0; e < 8; ++e) { x[e] = x[e] - lam * y[e]; s += x[e] * x[e]; }
        s += __shfl_xor(s, 1); s += __shfl_xor(s, 2); s += __shfl_xor(s, 4); s += __shfl_xor(s, 8); s += __shfl_xor(s, 16);
        const float rstd = 1.0f / sqrtf(s * (1.f / 256.f) + EPS);
#pragma unroll
        for (int e = 0; e < 8; ++e) x[e] = x[e] * rstd * gs[e];
        v4u o; o.x = pk2(x[0], x[1]); o.y = pk2(x[2], x[3]); o.z = pk2(x[4], x[5]); o.w = pk2(x[6], x[7]);
        *(GAS v4u*)(Oc + (size_t)m * DM + h * 256 + e0) = o;
    }
}
__device__ __forceinline__ void fill_lut(Frame& F, const float* rel_bias) {
    LAS float* lut = (LAS float*)(F.lds + RING_OFF + att::LDS_LUT);
    for (int i = F.tid; i < 32 * 128; i += NWAVES * 64) { const int m = i >> 7, d = i & 127; lut[i] = rel_bias[T5_BUCKET[d] * 32 + m] * LOG2E; }
    __syncthreads();
}

typedef const __attribute__((address_space(4))) Args* ArgsP;
#define TIDP() do { int t_ = threadIdx.x; asm volatile("" : "+v"(t_)); F.tid = t_; F.lane = t_ & 63; F.wave = __builtin_amdgcn_readfirstlane(t_ >> 6); } while (0)
#define ARGP() ArgsP ap = (ArgsP)__builtin_amdgcn_kernarg_segment_ptr(); asm volatile("" : "+s"(ap))
__global__ void __launch_bounds__(NWAVES * 64, 2) fwd_kernel(Args args) {
    extern __shared__ __attribute__((aligned(16))) unsigned char lds[];
    Frame F;
    F.lds = (LAS unsigned char*)lds;
    F.MISC = (volatile LAS unsigned*)(F.lds + MISC_OFF);
    F.tid = threadIdx.x; F.lane = F.tid & 63; F.wave = __builtin_amdgcn_readfirstlane(F.tid >> 6);
    F.G = gridDim.x; { const int bx = blockIdx.x; F.vcu = (F.G % 8 == 0) ? (bx % 8) * (F.G / 8) + bx / 8 : bx; }
    { ARGP(); F.ctl = (gu32*)(ap->ws + WS_CTL); }
#define A_x        (ap->in[0])
#define A_rel_bias (ap->in[1])
#define A_g_attn   (ap->in[2])
#define A_g_ffn    (ap->in[3])
#define A_w_qkv    (ap->in[4])
#define A_w_o_a    (ap->in[5])
#define A_g_q_a    (ap->in[6])
#define A_g_k_a    (ap->in[7])
#define A_lam_qk   (ap->in[8])
#define A_g_sub    (ap->in[9])
#define A_g_kvn    (ap->in[10])
#define A_w_kv     (ap->in[11])
#define A_g_k_sh   (ap->in[12])
#define A_w_q_b    (ap->in[13])
#define A_w_o_b    (ap->in[14])
#define A_g_q_b    (ap->in[15])
#define A_sinks    (ap->in[16])
#define A_w_gate   (ap->in[17])
#define A_w_up     (ap->in[18])
#define A_w_down   (ap->in[19])
#define A_out      (ap->out)
#define WSB(off) ((bf16*)(ap->ws + (off)))
#define A_Wqkv_t WSB(WS_WQKV)
#define A_Woa_t  WSB(WS_WOA)
#define A_Wgu0_t WSB(WS_WGU0)
#define A_Wd0_t  WSB(WS_WD0)
#define A_Wkvq_t WSB(WS_WKVQ)
#define A_Wob_t  WSB(WS_WOB)
#define A_Wgu1_t WSB(WS_WGU1)
#define A_Wd1_t  WSB(WS_WD1)
#define A_H  WSB(WS_H)
#define A_R1 WSB(WS_R1)
#define A_R2 WSB(WS_R2)
    for (int u = F.tid; u < (LDS_BYTES - LDSCTL_OFF) / 4; u += NWAVES * 64) ((LAS unsigned*)(F.lds + LDSCTL_OFF))[u] = 0u;
    __syncthreads();
    XcdBarrier bar = xcd_barrier_post((unsigned*)(F.ctl + CW_BAR), F.MISC + 8);
#define GRID_BAR() xcd_barrier(bar)
#ifndef PH_MASK
#define PH_MASK 0x1ffff
#endif
#define PH(k) if constexpr (((PH_MASK) >> (k)) & 1)

    PH(0)
    {
        ARGP(); TIDP();
        LAS float* scr = (LAS float*)(F.lds + RING_OFF + F.wave * 16384);
        const int gw = F.vcu * NWAVES + F.wave, NGW = F.G * NWAVES;
        constexpr int I_QKV = (DM / 64) * (NQKV / 32), I_SQ = (DM / 64) * (DM / 32), I_GU = (DM / 64) * (DFF / 32), I_D = (DFF / 64) * (DM / 32), I_KV = (DM / 64) * (2048 / 32);
        constexpr int NITEMS = I_QKV + I_SQ + 2 * I_GU + I_D + I_KV + I_SQ + I_SQ + 2 * I_GU + I_D;
        for (int it = gw; it < NITEMS; it += NGW) {
            int r = it; const float* W; int K, N; bf16* WT; const float* g; int mode, roff = 0;
            if (r < I_QKV) { W = A_w_qkv; K = DM; N = NQKV; WT = A_Wqkv_t; g = A_g_attn; mode = 0; }
            else if ((r -= I_QKV) < I_SQ) { W = A_w_o_a; K = DM; N = DM; WT = A_Woa_t; g = nullptr; mode = 0; }
            else if ((r -= I_SQ) < I_GU) { W = A_w_gate; K = DM; N = DFF; WT = A_Wgu0_t; g = A_g_ffn; mode = 1; }
            else if ((r -= I_GU) < I_GU) { W = A_w_up; K = DM; N = DFF; WT = A_Wgu0_t; g = A_g_ffn; mode = 2; }
            else if ((r -= I_GU) < I_D) { W = A_w_down; K = DFF; N = DM; WT = A_Wd0_t; g = nullptr; mode = 0; }
            else if ((r -= I_D) < I_KV) { W = A_w_kv; K = DM; N = 2048; WT = A_Wkvq_t; g = A_g_kvn; mode = 0; }
            else if ((r -= I_KV) < I_SQ) { W = A_w_q_b; K = DM; N = DM; WT = A_Wkvq_t; g = A_g_attn + DM; mode = 0; roff = 2048; }
            else if ((r -= I_SQ) < I_SQ) { W = A_w_o_b; K = DM; N = DM; WT = A_Wob_t; g = nullptr; mode = 0; }
            else if ((r -= I_SQ) < I_GU) { W = A_w_gate + (size_t)DM * DFF; K = DM; N = DFF; WT = A_Wgu1_t; g = A_g_ffn + DM; mode = 1; }
            else if ((r -= I_GU) < I_GU) { W = A_w_up + (size_t)DM * DFF; K = DM; N = DFF; WT = A_Wgu1_t; g = A_g_ffn + DM; mode = 2; }
            else { r -= I_GU; W = A_w_down + (size_t)DFF * DM; K = DFF; N = DM; WT = A_Wd1_t; g = nullptr; mode = 0; }
            const int nblk = N / 32, kb = r / nblk, nb = r - kb * nblk, n0 = nb * 32;
            const int drow0 = mode == 0 ? roff + n0 : (n0 >> 7) * 256 + (n0 & 127) + (mode == 2 ? 128 : 0);
            transpose_item(W, K, N, WT, drow0, g, scr, kb * 64, n0, F.lane);
        }
        rms_rows(F, A_x, A_H);
    }
    GRID_BAR();
    for (int layer = 0; layer < 2; ++layer) {
        const bool L0 = layer == 0;
        const int NP = L0 ? NQKV : NKVQ;
        PH(1)
        {
            ARGP();
            pg8::Gemm g{A_H, L0 ? A_Wqkv_t : A_Wkvq_t, M, NP, DM, DM}; pg8::StaticOrder S; S.init(M, NP, F.G, (int)blockIdx.x);
            pg8::EpiStoreBf16 E{A_R1, NQKV};
            pg8::gemm_phase<pg8::EpiStoreBf16, pg8::StaticOrder, true, true>(F.lds + RING_OFF, g, S, E);
        }
        GRID_BAR();
        PH(2)
        { ARGP(); TIDP(); if (L0) head_norm(F, A_R1, NQKV, 16, 8, 0, 4096, A_g_q_a, QSCALE, A_g_k_a, 1.0f);
          else    head_norm(F, A_R1, NQKV, 10, 2, 0, 2048, A_g_k_sh, 1.0f, A_g_q_b, QSCALE); }
        GRID_BAR();
        PH(3)
        {
            ARGP(); TIDP();
            fill_lut(F, A_rel_bias);
            constexpr int NITEM = 2048;
            const int W = L0 ? (1 << 30) : 128;
            const float ninf = -__builtin_inff();
            const att::Stg stg = att::make_stg<NQKV>(F.wave, F.lane);
#define ATT_REF(r, L, pass) do { if (L0) { const int bph = (L) >> 4, xx = (L) & 15, qb = (pass) ? 31 - xx : xx; const int b = bph >> 6, ph = bph & 63, map = ph >> 1, half = ph & 1, hh = map >> 1; \
                const bf16* base = A_R1 + (size_t)b * SEQ * NQKV; \
                r.Q = base + (size_t)qb * 256 * NQKV + map * 128; r.K = base + 4096 + map * 128; r.V = base + 8192 + hh * 256 + half * 128; \
                r.O = A_R2 + ((size_t)b * SEQ + (size_t)qb * 256) * 8192 + map * 256 + half * 128; r.P0 = qb * 256; r.map = map; r.sink2 = ninf; } \
            else { const int bh = (L) >> 5, qb = (L) & 31, b = bh >> 5, h = bh & 31; const bf16* base = A_R1 + (size_t)b * SEQ * NQKV; \
                r.Q = base + (size_t)qb * 256 * NQKV + 2048 + h * 128; r.K = base + (h >> 2) * 128; r.V = base + 1024 + (h >> 2) * 128; \
                r.O = A_R2 + ((size_t)b * SEQ + (size_t)qb * 256) * 8192 + h * 128; r.P0 = qb * 256; r.map = h; r.sink2 = A_sinks[h] * LOG2E; } } while (0)
            int L = blockIdx.x; asm volatile("" : "+s"(L));
            if (L < NITEM) {
                int pass = 0; att::BlockRef cur; ATT_REF(cur, L, 0); att::Seam S;
                att::attn_prime<NQKV>(cur, W, (char*)lds + RING_OFF, S, stg, F.tid);
                for (;;) {
                    const bool more_pass = L0 && pass == 0, more_item = L + (int)gridDim.x < NITEM, last = !more_pass && !more_item;
                    int passn = pass + 1, Ln = L;
                    if (!more_pass) { passn = 0; Ln = more_item ? L + (int)gridDim.x : L; }
                    att::BlockRef nxt = cur; if (!last) ATT_REF(nxt, Ln, passn);
                    att::attn_block<NQKV, 8192>(cur, nxt, SEQ, W, (char*)lds + RING_OFF, S, stg, F.tid);
                    if (last) break;
                    cur = nxt; pass = passn; L = Ln;
                }
            }
#undef ATT_REF
        }
        GRID_BAR();
        PH(4)
        if (L0) { ARGP(); TIDP(); diff_combine(F, A_R2, A_H, A_lam_qk, A_g_sub); }
        if (L0) GRID_BAR();
        PH(5)
        {
            ARGP();
            pg8::Gemm g{L0 ? A_H : A_R2, L0 ? A_Woa_t : A_Wob_t, M, DM, DM, L0 ? DM : 8192};     pg8::StaticOrder S; S.init(M, DM, F.G, (int)blockIdx.x);
            pg8::EpiResF32 E{L0 ? A_x : (const float*)A_out, A_out, DM};
            pg8::gemm_phase<pg8::EpiResF32, pg8::StaticOrder, true, true>(F.lds + RING_OFF, g, S, E);
        }
        GRID_BAR();
        PH(6)
        { ARGP(); TIDP(); rms_rows(F, A_out, A_H); }
        GRID_BAR();
        PH(7)
        {
            ARGP();
            pg8::Gemm g{A_H, L0 ? A_Wgu0_t : A_Wgu1_t, M, NGU, DM, DM}; pg8::StaticOrder S; S.init(M, NGU, F.G, (int)blockIdx.x);
            pg8::EpiSwiGLU E{A_R1, DFF};
            pg8::gemm_phase<pg8::EpiSwiGLU, pg8::StaticOrder, true, true>(F.lds + RING_OFF, g, S, E);
        }
        GRID_BAR();
        PH(8)
        {
            ARGP();
            pg8::Gemm g{A_R1, L0 ? A_Wd0_t : A_Wd1_t, M, DM, DFF, DFF}; pg8::StaticOrder S; S.init(M, DM, F.G, (int)blockIdx.x);
            pg8::EpiResF32 E{A_out, A_out, DM};
            pg8::gemm_phase<pg8::EpiResF32, pg8::StaticOrder, true, true>(F.lds + RING_OFF, g, S, E);
        }
        if (L0) {
            GRID_BAR();
            PH(9)
            { ARGP(); TIDP(); rms_rows(F, A_out, A_H); }
            GRID_BAR();
        }
    }
}

extern "C" void kernel_launch(void* const* d_in, const int* in_sizes, int n_in, void* d_out, int out_size, void* d_ws, size_t ws_size, hipStream_t stream) {
    static int grid = 0;
    if (grid == 0) {
        if (n_in != 20 || in_sizes[0] != M * DM || out_size != M * DM || ws_size < WS_END) { fprintf(stderr, "kernel_launch: shape/workspace mismatch: n_in %d in0 %d out %d ws %zu (need %zu)\n", n_in, n_in > 0 ? in_sizes[0] : -1, out_size, ws_size, (size_t)WS_END); grid = -1; return; }
        int dev = 0, cus = 0, per_cu = 0;
        if (hipGetDevice(&dev) != hipSuccess || hipDeviceGetAttribute(&cus, hipDeviceAttributeMultiprocessorCount, dev) != hipSuccess) { grid = -1; return; }
        if (hipFuncSetAttribute((const void*)fwd_kernel, hipFuncAttributeMaxDynamicSharedMemorySize, LDS_BYTES) != hipSuccess) { fprintf(stderr, "kernel_launch: hipFuncSetAttribute failed\n"); grid = -1; return; }
        if (hipOccupancyMaxActiveBlocksPerMultiprocessor(&per_cu, (const void*)fwd_kernel, NWAVES * 64, LDS_BYTES) != hipSuccess || per_cu < 1) { fprintf(stderr, "kernel_launch: occupancy query says %d blocks per CU\n", per_cu); grid = -1; (void)hipGetLastError(); return; }
        grid = cus;
    }
    if (grid < 0) return;
    if (hipMemsetAsync((char*)d_ws + WS_CTL, 0, CTL_ZERO_BYTES, stream) != hipSuccess) return;
    Args a{};
    for (int i = 0; i < 20; ++i) a.in[i] = (const float*)d_in[i];
    a.out = (float*)d_out; a.ws = (unsigned char*)d_ws;
    hipLaunchKernelGGL(fwd_kernel, dim3(grid), dim3(NWAVES * 64), LDS_BYTES, stream, a);
}
```

```cpp
#include <hip/hip_runtime.h>
#include <hip/hip_bf16.h>
#include <cstdio>
#include <cstdint>
#include <cmath>

__device__ __forceinline__ int phase_tid(int wave_s) { int lane; asm volatile("v_mbcnt_lo_u32_b32 %0, -1, 0\n\tv_mbcnt_hi_u32_b32 %0, -1, %0" : "=v"(lane)); return wave_s * 64 + lane; }

__device__ __forceinline__ float shflx(float v, int k, int lane) { return __builtin_bit_cast(float, __builtin_amdgcn_ds_bpermute((lane ^ k) << 2, __builtin_bit_cast(int, v))); }
template <int CTRL> __device__ __forceinline__ float dppx(float a) { return __builtin_bit_cast(float, __builtin_amdgcn_update_dpp(0, __builtin_bit_cast(int, a), CTRL, 0xf, 0xf, true)); }
__device__ __forceinline__ float swz16(float a) { return __builtin_bit_cast(float, __builtin_amdgcn_ds_swizzle(__builtin_bit_cast(int, a), 0x401F)); }
__device__ __forceinline__ float sum16(float a) { a += dppx<0xB1>(a); a += dppx<0x4E>(a); a += dppx<0x141>(a); a += dppx<0x140>(a); return a; }
namespace pg8 {
#define PG8_LAS __attribute__((address_space(3)))
typedef unsigned short bf16_t;
typedef short bf16x8 __attribute__((ext_vector_type(8)));
typedef float f32x4 __attribute__((ext_vector_type(4)));
typedef unsigned u32x4 __attribute__((ext_vector_type(4)));
constexpr int BM = 256, BK = 64, HALF = 128, HTB = HALF * BK * 2  , STAGE_BYTES = 8 * HTB, NXCD = 8, WGM = 8;

__host__ __device__ __forceinline__ int lds_byte(int r, int c) { const int st = (r >> 4) * 2 + (c >> 5), rr = r & 15, cc = c & 31, ob = rr * 64 + cc * 2; return st * 1024 + (ob ^ (((ob >> 9) & 1) << 5)); }
__host__ __device__ __forceinline__ void stage_rc(int b, int& R, int& C) { const int st = b / 1024, sb = b % 1024, swz = sb ^ (((sb >> 9) & 1) << 5); R = (st >> 1) * 16 + swz / 64; C = (st & 1) * 32 + (swz % 64) / 2; }
__host__ __device__ __forceinline__ int perm32(int rho) { const int n = rho >> 4, i = rho & 15; return 8 * (i >> 2) + 4 * n + (i & 3); }

struct Unit { int pm, pn; };
struct Gemm { const bf16_t* A; const bf16_t* Bt; int M, N, K, lda; };

struct StaticOrder {
    int nM, nN, nwg, G, c, wgm;
    __host__ __device__ void init(int M, int N, int G_, int c_, int wgm_ = WGM) { nM = M / BM; nN = N / BM; nwg = nM * nN; G = G_; c = c_; wgm = wgm_; }
    __host__ __device__ bool next(int i, Unit& u) const {
        const long L = (long)i * G + c; if (L >= nwg) return false;
        int wgid = (int)L; { const int q = nwg / NXCD, r = nwg % NXCD, xcd = wgid % NXCD, off = wgid / NXCD; wgid = (xcd < r ? xcd * (q + 1) : r * (q + 1) + (xcd - r) * q) + off; }
        const int nig = wgm * nN, gid = wgid / nig, fm = gid * wgm, gsz = (nM - fm) < wgm ? (nM - fm) : wgm;
        u.pm = fm + ((wgid % nig) % gsz); u.pn = (wgid % nig) / gsz; return true;
    }
    __device__ __forceinline__ void a_ready(const Unit&) const {}
    __device__ __forceinline__ void done(const Unit&) const {}
};

__device__ __forceinline__ unsigned cvt_pk_bf16(float lo, float hi) { unsigned r; asm volatile("v_cvt_pk_bf16_f32 %0, %1, %2" : "=v"(r) : "v"(lo), "v"(hi)); return r; }
typedef float f32x2 __attribute__((ext_vector_type(2)));
struct EpiStoreBf16 {
    static constexpr bool PERM = true, AFTER_DRAIN = false;
    bf16_t* O; int ldc; const float* ss; float inv_k, eps;
    struct State { float rs[2][4]; };
    __device__ __forceinline__ void prep(State& s, const Unit& u, int wr, int fr) const {
        const int row0 = u.pm * BM + wr * 64 + fr; float t[2][4];
#pragma unroll
        for (int ai = 0; ai < 2; ++ai)
#pragma unroll
            for (int m = 0; m < 4; ++m) t[ai][m] = __builtin_nontemporal_load(ss + row0 + ai * HALF + m * 16);
#pragma unroll
        for (int ai = 0; ai < 2; ++ai)
#pragma unroll
            for (int m = 0; m < 4; ++m) s.rs[ai][m] = __builtin_amdgcn_rsqf(t[ai][m] * inv_k + eps);
    }
    __device__ __forceinline__ void operator()(const f32x4 (&acc)[2][2][4][2], const Unit& u, int wr, int wc, int fr, int fq, const State& st) const {
        const int row0 = u.pm * BM + wr * 64 + fr, col0 = u.pn * BM + wc * 32 + 8 * fq;
#pragma unroll
        for (int ai = 0; ai < 2; ++ai)
#pragma unroll
            for (int m = 0; m < 4; ++m) { bf16_t* rowp = O + (size_t)(row0 + ai * HALF + m * 16) * ldc + col0; const float r = st.rs[ai][m];
#pragma unroll
                for (int bj = 0; bj < 2; ++bj) { const f32x4 v0 = acc[ai][bj][m][0] * r, v1 = acc[ai][bj][m][1] * r;
                    u32x4 w; w.x = cvt_pk_bf16(v0[0], v0[1]); w.y = cvt_pk_bf16(v0[2], v0[3]); w.z = cvt_pk_bf16(v1[0], v1[1]); w.w = cvt_pk_bf16(v1[2], v1[3]);
                    *(u32x4*)(rowp + bj * HALF) = w; } }
    }
};
struct EpiProj {
    static constexpr bool PERM = true, AFTER_DRAIN = false;
    bf16_t* O; int ldc; const float* ss; float inv_k, eps;
    const float* gA; const float* gB; int a0, a1, b0, b1; float sA, sB, heps;
    PG8_LAS float* xs;
    struct State { float rs[2][4]; };
    __device__ __forceinline__ void prep(State& s, const Unit& u, int wr, int fr) const {
        const int row0 = u.pm * BM + wr * 64 + fr; float t[2][4];
#pragma unroll
        for (int ai = 0; ai < 2; ++ai)
#pragma unroll
            for (int m = 0; m < 4; ++m) t[ai][m] = __builtin_nontemporal_load(ss + row0 + ai * HALF + m * 16);
#pragma unroll
        for (int ai = 0; ai < 2; ++ai)
#pragma unroll
            for (int m = 0; m < 4; ++m) s.rs[ai][m] = __builtin_amdgcn_rsqf(t[ai][m] * inv_k + eps);
    }
    __device__ __forceinline__ void operator()(const f32x4 (&acc)[2][2][4][2], const Unit& u, int wr, int wc, int fr, int fq, const State& st) const {
        const int row0 = u.pm * BM + wr * 64 + fr, col0 = u.pn * BM + wc * 32 + 8 * fq;
        const int mode = (u.pn >= a0 && u.pn < a1) ? 1 : ((u.pn >= b0 && u.pn < b1) ? 2 : 0);
        float hr[2][2][4];
        f32x4 gv[2] = {(f32x4){1.f, 1.f, 1.f, 1.f}, (f32x4){1.f, 1.f, 1.f, 1.f}};
        if (mode) {
            const int lane = fq * 16 + fr;
            float sv[2][4][2];
#pragma unroll
            for (int ai = 0; ai < 2; ++ai)
#pragma unroll
                for (int m = 0; m < 4; ++m)
#pragma unroll
                    for (int bj = 0; bj < 2; ++bj) { const f32x4 v0 = acc[ai][bj][m][0] * st.rs[ai][m], v1 = acc[ai][bj][m][1] * st.rs[ai][m];
                        sv[ai][m][bj] = (v0[0] * v0[0] + v0[1] * v0[1]) + (v0[2] * v0[2] + v0[3] * v0[3]) + (v1[0] * v1[0] + v1[1] * v1[1]) + (v1[2] * v1[2] + v1[3] * v1[3]); }
#pragma unroll
            for (int ai = 0; ai < 2; ++ai)
#pragma unroll
                for (int m = 0; m < 4; ++m)
#pragma unroll
                    for (int bj = 0; bj < 2; ++bj) sv[ai][m][bj] += swz16(sv[ai][m][bj]);
            float tv[2][4][2];
#pragma unroll
            for (int ai = 0; ai < 2; ++ai)
#pragma unroll
                for (int m = 0; m < 4; ++m)
#pragma unroll
                    for (int bj = 0; bj < 2; ++bj) tv[ai][m][bj] = shflx(sv[ai][m][bj], 32, lane);
            if (fq == 0) {
#pragma unroll
                for (int ai = 0; ai < 2; ++ai)
#pragma unroll
                    for (int m = 0; m < 4; ++m)
#pragma unroll
                        for (int bj = 0; bj < 2; ++bj) xs[((wr * 2 + bj) * 128 + ai * 64 + m * 16 + fr) * 4 + wc] = sv[ai][m][bj] + tv[ai][m][bj];
            }
            const float* g = mode == 1 ? gA : gB; const float sc = mode == 1 ? sA : sB;
            gv[0] = *(const f32x4*)(g + wc * 32 + 8 * fq) * sc; gv[1] = *(const f32x4*)(g + wc * 32 + 8 * fq + 4) * sc;
            asm volatile("s_waitcnt lgkmcnt(0)" ::: "memory"); __builtin_amdgcn_s_barrier(); asm volatile("" ::: "memory");
#pragma unroll
            for (int ai = 0; ai < 2; ++ai)
#pragma unroll
                for (int m = 0; m < 4; ++m)
#pragma unroll
                    for (int bj = 0; bj < 2; ++bj) { const f32x4 t = *(const PG8_LAS f32x4*)(xs + ((wr * 2 + bj) * 128 + ai * 64 + m * 16 + fr) * 4);
                        hr[ai][bj][m] = __builtin_amdgcn_rsqf(((t[0] + t[1]) + (t[2] + t[3])) * (1.0f / 128.0f) + heps) * st.rs[ai][m]; }
        } else {
#pragma unroll
            for (int ai = 0; ai < 2; ++ai)
#pragma unroll
                for (int m = 0; m < 4; ++m) { hr[ai][0][m] = st.rs[ai][m]; hr[ai][1][m] = st.rs[ai][m]; }
        }
#pragma unroll
        for (int ai = 0; ai < 2; ++ai)
#pragma unroll
            for (int m = 0; m < 4; ++m) { bf16_t* rowp = O + (size_t)(row0 + ai * HALF + m * 16) * ldc + col0;
#pragma unroll
                for (int bj = 0; bj < 2; ++bj) { const f32x4 v0 = acc[ai][bj][m][0] * hr[ai][bj][m] * gv[0], v1 = acc[ai][bj][m][1] * hr[ai][bj][m] * gv[1];
                    u32x4 w; w.x = cvt_pk_bf16(v0[0], v0[1]); w.y = cvt_pk_bf16(v0[2], v0[3]); w.z = cvt_pk_bf16(v1[0], v1[1]); w.w = cvt_pk_bf16(v1[2], v1[3]);
                    *(u32x4*)(rowp + bj * HALF) = w; } }
    }
};
struct EpiSwiGLU {
    static constexpr bool PERM = true, AFTER_DRAIN = false;
    bf16_t* O; int ldc; const float* ss; float inv_k, eps;
    struct State { float rs[2][4]; };
    __device__ __forceinline__ void prep(State& s, const Unit& u, int wr, int fr) const {
        const int row0 = u.pm * BM + wr * 64 + fr; float t[2][4];
#pragma unroll
        for (int ai = 0; ai < 2; ++ai)
#pragma unroll
            for (int m = 0; m < 4; ++m) t[ai][m] = __builtin_nontemporal_load(ss + row0 + ai * HALF + m * 16);
#pragma unroll
        for (int ai = 0; ai < 2; ++ai)
#pragma unroll
            for (int m = 0; m < 4; ++m) s.rs[ai][m] = __builtin_amdgcn_rsqf(t[ai][m] * inv_k + eps);
    }
    __device__ __forceinline__ void operator()(const f32x4 (&acc)[2][2][4][2], const Unit& u, int wr, int wc, int fr, int fq, const State& st) const {
        const int row0 = u.pm * BM + wr * 64 + fr, col0 = u.pn * HALF + wc * 32 + 8 * fq;
#pragma unroll
        for (int ai = 0; ai < 2; ++ai)
#pragma unroll
            for (int m = 0; m < 4; ++m) { bf16_t* rowp = O + (size_t)(row0 + ai * HALF + m * 16) * ldc + col0; const float rstd = st.rs[ai][m];
                float r[8];
#pragma unroll
                for (int n = 0; n < 2; ++n)
#pragma unroll
                    for (int e = 0; e < 4; ++e) { const float g = acc[ai][0][m][n][e] * rstd, up = acc[ai][1][m][n][e] * rstd;
                        const float s = __builtin_amdgcn_rcpf(1.0f + __builtin_amdgcn_exp2f(-1.4426950408889634f * g));
                        r[n * 4 + e] = g * s * up; }
                u32x4 w; w.x = cvt_pk_bf16(r[0], r[1]); w.y = cvt_pk_bf16(r[2], r[3]); w.z = cvt_pk_bf16(r[4], r[5]); w.w = cvt_pk_bf16(r[6], r[7]);
                *(u32x4*)rowp = w; }
    }
};
struct EpiResF32 {
    static constexpr bool PERM = true, AFTER_DRAIN = false;
    const float* res32; const bf16_t* res16; float* out32; int ldc; bf16_t* xb; float* ss;
    struct State {};
    __device__ __forceinline__ void prep(State&, const Unit&, int, int) const {}
    __device__ __forceinline__ void operator()(const f32x4 (&acc)[2][2][4][2], const Unit& u, int wr, int wc, int fr, int fq, const State&) const {
        const int row0 = u.pm * BM + wr * 64 + fr, col0 = u.pn * BM + wc * 32 + 8 * fq;
        float sacc[2][4];
#pragma unroll
        for (int ai = 0; ai < 2; ++ai)
#pragma unroll
            for (int m = 0; m < 4; ++m) { const int row = row0 + ai * HALF + m * 16; const size_t off = (size_t)row * ldc + col0;
                f32x4 rv[2][2];
                if (res32) {
#pragma unroll
                    for (int bj = 0; bj < 2; ++bj)
#pragma unroll
                        for (int n = 0; n < 2; ++n) rv[bj][n] = *(const f32x4*)(res32 + off + bj * HALF + n * 4);
                } else {
#pragma unroll
                    for (int bj = 0; bj < 2; ++bj) { const u32x4 w = *(const u32x4*)(res16 + off + bj * HALF);
                        rv[bj][0] = (f32x4){__uint_as_float(w.x << 16), __uint_as_float(w.x & 0xffff0000u), __uint_as_float(w.y << 16), __uint_as_float(w.y & 0xffff0000u)};
                        rv[bj][1] = (f32x4){__uint_as_float(w.z << 16), __uint_as_float(w.z & 0xffff0000u), __uint_as_float(w.w << 16), __uint_as_float(w.w & 0xffff0000u)}; }
                }
                float s = 0.f;
#pragma unroll
                for (int bj = 0; bj < 2; ++bj) { const f32x4 v0 = rv[bj][0] + acc[ai][bj][m][0], v1 = rv[bj][1] + acc[ai][bj][m][1];
                    if (out32) { *(f32x4*)(out32 + off + bj * HALF) = v0; *(f32x4*)(out32 + off + bj * HALF + 4) = v1; }
                    if (xb) { u32x4 w; w.x = cvt_pk_bf16(v0[0], v0[1]); w.y = cvt_pk_bf16(v0[2], v0[3]); w.z = cvt_pk_bf16(v1[0], v1[1]); w.w = cvt_pk_bf16(v1[2], v1[3]); *(u32x4*)(xb + off + bj * HALF) = w;
                        s += ((v0[0] * v0[0] + v0[1] * v0[1]) + (v0[2] * v0[2] + v0[3] * v0[3])) + ((v1[0] * v1[0] + v1[1] * v1[1]) + (v1[2] * v1[2] + v1[3] * v1[3])); } }
                sacc[ai][m] = s; }
        if (xb) {
#pragma unroll
            for (int ai = 0; ai < 2; ++ai)
#pragma unroll
                for (int m = 0; m < 4; ++m) sacc[ai][m] += swz16(sacc[ai][m]);
            float tacc[2][4];
#pragma unroll
            for (int ai = 0; ai < 2; ++ai)
#pragma unroll
                for (int m = 0; m < 4; ++m) tacc[ai][m] = shflx(sacc[ai][m], 32, fq * 16 + fr);
#pragma unroll
            for (int ai = 0; ai < 2; ++ai)
#pragma unroll
                for (int m = 0; m < 4; ++m) { if (fq == 0) unsafeAtomicAdd(ss + row0 + ai * HALF + m * 16, sacc[ai][m] + tacc[ai][m]); }
        }
    }
};
template <class Epi, class Sched, bool ALIGN_EPI = false, bool SP2 = false>
__device__ __forceinline__ void gemm_phase(PG8_LAS unsigned char* lds, const Gemm g, const Sched& S, const Epi& E, int tid) {
    asm volatile("" : "+v"(tid));
    const int wid = __builtin_amdgcn_readfirstlane(tid >> 6), lane = tid & 63, wr = wid >> 2, wc = wid & 3, fr = lane & 15, fq = lane >> 4;
    const int K = g.K, nt = K / BK;
    unsigned voffA[2], voffB[2];
#pragma unroll
    for (int i = 0; i < 2; ++i) { int R, C; stage_rc(tid * 16 + i * 8192, R, C); const int Rb = Epi::PERM ? ((R & ~31) + perm32(R & 31)) : R;
        voffA[i] = (unsigned)(R * g.lda + C) * 2u; voffB[i] = (unsigned)(Rb * K + C) * 2u; }
    const size_t kstep = (size_t)(BK * 2);
    const size_t hstep = (size_t)HALF * K * 2;
    const size_t hstepA = (size_t)HALF * g.lda * 2, tstepA = 2 * hstepA;
    const size_t tstep = 2 * hstep;
    const unsigned ldsw = (unsigned)wid * 1024u;
    const int aoff = lds_byte(wr * 64 + fr, fq * 8), boff = lds_byte(wc * 32 + fr, fq * 8);
#define PG8_SA(b, h) (((b) * 2 + (h)) * HTB)
#define PG8_SB(b, h) ((4 + (b) * 2 + (h)) * HTB)
#define PG8_STAGE(bufoff, gbase, voff) do { _Pragma("unroll") for (int _i = 0; _i < 2; ++_i) \
        __builtin_amdgcn_global_load_lds((const unsigned*)((const char*)(gbase) + (voff)[_i]), (PG8_LAS unsigned*)(lds + (bufoff) + ldsw + _i * 8192), 16, 0, 0); } while (0)
#define PG8_LDA(dst, b, h) do { _Pragma("unroll") for (int m = 0; m < 4; ++m) _Pragma("unroll") for (int k = 0; k < 2; ++k) dst[m][k] = *(const PG8_LAS bf16x8*)(lds + PG8_SA(b, h) + aoff + m * 2048 + k * 1024); } while (0)
#define PG8_LDB(dst, b, h) do { _Pragma("unroll") for (int n = 0; n < 2; ++n) _Pragma("unroll") for (int k = 0; k < 2; ++k) dst[n][k] = *(const PG8_LAS bf16x8*)(lds + PG8_SB(b, h) + boff + n * 2048 + k * 1024); } while (0)
#define PG8_MMA(ai, bj, At, Bt) do { __builtin_amdgcn_s_setprio(1); _Pragma("unroll") for (int m = 0; m < 4; ++m) _Pragma("unroll") for (int n = 0; n < 2; ++n) _Pragma("unroll") for (int k = 0; k < 2; ++k) \
        acc[ai][bj][m][n] = __builtin_amdgcn_mfma_f32_16x16x32_bf16(Bt[n][k], At[m][k], acc[ai][bj][m][n], 0, 0, 0); __builtin_amdgcn_s_setprio(0); } while (0)
#define PG8_WAIT_V(n) asm volatile("s_waitcnt vmcnt(" #n ")" ::: "memory")
#define PG8_WAIT_L(n) asm volatile("s_waitcnt lgkmcnt(" #n ")" ::: "memory")
#define PG8_BAR __builtin_amdgcn_s_barrier()
#define PG8_SCHED __builtin_amdgcn_sched_barrier(0)
    Unit cur, nxt; int ui = 0;
    if (!S.next(0, cur)) return;
    typename Epi::State est; int est_pm = -1;
    f32x4 acc[2][2][4][2];
#pragma unroll
    for (int a = 0; a < 2; ++a)
#pragma unroll
        for (int b = 0; b < 2; ++b)
#pragma unroll
            for (int m = 0; m < 4; ++m)
#pragma unroll
                for (int n = 0; n < 2; ++n) acc[a][b][m][n] = (f32x4){0.f, 0.f, 0.f, 0.f};
    bf16x8 At[4][2], B0[2][2], B1[2][2];
    const char* cA = (const char*)g.A + (size_t)cur.pm * tstepA; const char* cB = (const char*)g.Bt + (size_t)cur.pn * tstep;
    S.a_ready(cur);
    if constexpr (SP2) {
        PG8_STAGE(PG8_SB(0, 0), cB, voffB); PG8_STAGE(PG8_SB(0, 1), cB + hstep, voffB); PG8_STAGE(PG8_SA(0, 0), cA, voffA); PG8_STAGE(PG8_SA(0, 1), cA + hstepA, voffA);
        if (wr == 1) PG8_BAR;
        PG8_WAIT_V(2); PG8_BAR;
        PG8_STAGE(PG8_SB(1, 0), cB + kstep, voffB); PG8_STAGE(PG8_SA(1, 0), cA + kstep, voffA); PG8_STAGE(PG8_SB(1, 1), cB + hstep + kstep, voffB);
        PG8_WAIT_V(6); PG8_BAR;
    } else {
        PG8_STAGE(PG8_SB(0, 0), cB, voffB); PG8_STAGE(PG8_SA(0, 0), cA, voffA); PG8_STAGE(PG8_SB(0, 1), cB + hstep, voffB); PG8_STAGE(PG8_SA(0, 1), cA + hstepA, voffA);
        if (wr == 1) PG8_BAR;
        PG8_WAIT_V(4); PG8_BAR;
        PG8_STAGE(PG8_SB(1, 0), cB + kstep, voffB); PG8_STAGE(PG8_SA(1, 0), cA + kstep, voffA); PG8_STAGE(PG8_SB(1, 1), cB + hstep + kstep, voffB);
        PG8_WAIT_V(6); PG8_BAR;
    }
    for (;;) {
        const bool has_next = S.next(ui + 1, nxt);
        const char* nA = has_next ? (const char*)g.A + (size_t)nxt.pm * tstepA : cA; const char* nB = has_next ? (const char*)g.Bt + (size_t)nxt.pn * tstep : cB;
        for (int t = 0; t < nt; t += 2) {
            const bool last = (t == nt - 2);
            const char* a1 = cA + (size_t)(t + 1) * kstep;
            const char* a2 = last ? nA : cA + (size_t)(t + 2) * kstep; const char* b2 = last ? nB : cB + (size_t)(t + 2) * kstep;
            const char* a3 = a2 + kstep; const char* b3 = b2 + kstep;
            if (last && has_next) S.a_ready(nxt);
            if constexpr (SP2) {
            PG8_LDB(B0, 0, 0); PG8_LDB(B1, 0, 1); PG8_SCHED; PG8_LDA(At, 0, 0); PG8_STAGE(PG8_SA(1, 1), a1 + hstepA, voffA);
            PG8_WAIT_V(8); PG8_WAIT_L(0); PG8_BAR; PG8_MMA(0, 0, At, B0); PG8_MMA(0, 1, At, B1); PG8_BAR; PG8_SCHED;
            PG8_LDA(At, 0, 1); PG8_STAGE(PG8_SB(0, 0), b2, voffB); PG8_STAGE(PG8_SB(0, 1), b2 + hstep, voffB); PG8_STAGE(PG8_SA(0, 0), a2, voffA);
            PG8_WAIT_V(8); PG8_WAIT_L(0); PG8_BAR; PG8_MMA(1, 0, At, B0); PG8_MMA(1, 1, At, B1); PG8_BAR; PG8_SCHED;
            PG8_LDB(B0, 1, 0); PG8_LDB(B1, 1, 1); PG8_SCHED; PG8_LDA(At, 1, 0); PG8_STAGE(PG8_SA(0, 1), a2 + hstepA, voffA);
            PG8_WAIT_V(8); PG8_WAIT_L(0); PG8_BAR; PG8_MMA(0, 0, At, B0); PG8_MMA(0, 1, At, B1); PG8_BAR; PG8_SCHED;
            PG8_LDA(At, 1, 1); PG8_STAGE(PG8_SB(1, 0), b3, voffB); PG8_STAGE(PG8_SB(1, 1), b3 + hstep, voffB); PG8_STAGE(PG8_SA(1, 0), a3, voffA);
            PG8_WAIT_V(8); PG8_WAIT_L(0); PG8_BAR; PG8_MMA(1, 0, At, B0); PG8_MMA(1, 1, At, B1); PG8_BAR; PG8_SCHED;
            } else {
            PG8_LDB(B0, 0, 0); PG8_SCHED; PG8_LDA(At, 0, 0); PG8_STAGE(PG8_SA(1, 1), a1 + hstepA, voffA);
            PG8_WAIT_L(8); PG8_BAR; PG8_WAIT_L(0); PG8_MMA(0, 0, At, B0); PG8_BAR; PG8_SCHED;
            PG8_LDB(B1, 0, 1); PG8_STAGE(PG8_SB(0, 0), b2, voffB);
            PG8_BAR; PG8_WAIT_L(0); PG8_MMA(0, 1, At, B1); PG8_BAR;
            PG8_LDA(At, 0, 1); PG8_STAGE(PG8_SA(0, 0), a2, voffA);
            PG8_BAR; PG8_WAIT_L(0); PG8_MMA(1, 0, At, B0); PG8_BAR; PG8_SCHED;
            PG8_STAGE(PG8_SB(0, 1), b2 + hstep, voffB);
            PG8_WAIT_V(6); PG8_BAR; PG8_MMA(1, 1, At, B1); PG8_BAR;
            PG8_LDB(B0, 1, 0); PG8_SCHED; PG8_LDA(At, 1, 0); PG8_STAGE(PG8_SA(0, 1), a2 + hstepA, voffA);
            PG8_WAIT_L(8); PG8_BAR; PG8_WAIT_L(0); PG8_MMA(0, 0, At, B0); PG8_BAR; PG8_SCHED;
            PG8_LDB(B1, 1, 1); PG8_STAGE(PG8_SB(1, 0), b3, voffB);
            PG8_BAR; PG8_WAIT_L(0); PG8_MMA(0, 1, At, B1); PG8_BAR;
            PG8_LDA(At, 1, 1); PG8_STAGE(PG8_SA(1, 0), a3, voffA);
            PG8_BAR; PG8_WAIT_L(0); PG8_MMA(1, 0, At, B0); PG8_BAR; PG8_SCHED;
            PG8_STAGE(PG8_SB(1, 1), b3 + hstep, voffB);
            PG8_WAIT_V(6); PG8_BAR; PG8_MMA(1, 1, At, B1); PG8_BAR;
            }
        }
        if constexpr (ALIGN_EPI) { if (wr == 0) PG8_BAR; }
        if constexpr (!Epi::AFTER_DRAIN) { if (cur.pm != est_pm) { E.prep(est, cur, wr, fr); est_pm = cur.pm; } E(acc, cur, wr, wc, fr, fq, est); S.done(cur); }
        if (!has_next) break;
#pragma unroll
        for (int a = 0; a < 2; ++a)
#pragma unroll
            for (int b = 0; b < 2; ++b)
#pragma unroll
                for (int m = 0; m < 4; ++m)
#pragma unroll
                    for (int n = 0; n < 2; ++n) acc[a][b][m][n] = (f32x4){0.f, 0.f, 0.f, 0.f};
        cur = nxt; cA = nA; cB = nB; ++ui;
        if constexpr (ALIGN_EPI) { if (wr == 1) PG8_BAR; }
    }
    PG8_WAIT_V(0);
    if constexpr (!ALIGN_EPI) { if (wr == 0) PG8_BAR; }
    PG8_BAR;
    if constexpr (Epi::AFTER_DRAIN) { E.fused(acc, cur, wr, wc, fr, fq, lds, wid, lane); S.done(cur); }
    (void)est_pm;
#undef PG8_SA
#undef PG8_SB
#undef PG8_STAGE
#undef PG8_LDA
#undef PG8_LDB
#undef PG8_MMA
#undef PG8_WAIT_V
#undef PG8_WAIT_L
#undef PG8_BAR
#undef PG8_SCHED
}
}
namespace att {
typedef unsigned short bf16;
typedef short bf16x8 __attribute__((ext_vector_type(8)));
typedef short s16x4 __attribute__((ext_vector_type(4)));
typedef float f32x16 __attribute__((ext_vector_type(16)));
typedef float f32x4 __attribute__((ext_vector_type(4)));
typedef unsigned u32x4 __attribute__((ext_vector_type(4)));
constexpr int D = 128, NW = 8, QBLK = 32, KVBLK = 64, QB = NW * QBLK;
constexpr int SHM_V = KVBLK * D * 2, SHM_K = KVBLK * D * 2;
constexpr int LDS_WS = 131072 + 512, LUTS = 160, LDS_LUT = LDS_WS + NW * 64 * 4, LDS_BND = LDS_LUT + 32 * LUTS * 4, LDS_BYTES = LDS_BND + 32 * 4;
#define KSWZ(row, colB) ((row) * 256 + ((colB) ^ (((row) & 7) << 4)))
#define SBAR() __builtin_amdgcn_sched_barrier(0)
__device__ __forceinline__ int v_st(int k, int c) { const int kk = (k & ~0xC) | ((k & 4) << 1) | ((k & 8) >> 1); return ((kk >> 3) * 4 + (c >> 5)) * 512 + ((kk & 7) * 32 + (c & 31)) * 2; }
__device__ __forceinline__ int v_rd_base(int lane) { return ((lane & 3) << 3) | (((lane >> 2) & 3) << 6) | (((lane >> 4) & 1) << 5) | (((lane >> 5) & 1) << 8); }
constexpr int v_rd_off(int d0, int ks, int half) { return d0 * 512 + ks * 4096 + half * 2048; }
__device__ __forceinline__ int crow(int r, int hi) { return (r & 3) + 8 * (r >> 2) + 4 * hi; }
__device__ __forceinline__ unsigned cvtpk(float lo, float hi) { unsigned r; asm volatile("v_cvt_pk_bf16_f32 %0, %1, %2" : "=v"(r) : "v"(lo), "v"(hi)); return r; }
__device__ __forceinline__ bf16x8 load8(const bf16* p) { return *reinterpret_cast<const bf16x8*>(p); }
__device__ __forceinline__ void bias_mask_tile(f32x16& p0, f32x16& p1, int dq, unsigned W, const float* lut) {
#pragma unroll
    for (int r = 0; r < 16; ++r) {
        const int c = (r & 3) + 8 * (r >> 2);
        const int d0 = dq - c, d1 = dq - c - 32;
        const int i0 = ((unsigned)d0 >= W) ? 128 : (d0 > 127 ? 127 : d0), i1 = ((unsigned)d1 >= W) ? 128 : (d1 > 127 ? 127 : d1);
        p0[r] += lut[i0]; p1[r] += lut[i1];
    }
}
__device__ __forceinline__ void partialSM(f32x16& p0) {
#pragma unroll
    for (int r = 0; r < 16; ++r) p0[r] = __builtin_amdgcn_exp2f(p0[r]);
}
__device__ __forceinline__ void finishSM(f32x16& p0, f32x16& p1, float& l_reg, bf16x8& pa0, bf16x8& pa1, bf16x8& pa2, bf16x8& pa3) {
#pragma unroll
    for (int r = 0; r < 16; ++r) p1[r] = __builtin_amdgcn_exp2f(p1[r]);
    float ps = 0;
#pragma unroll
    for (int r = 0; r < 16; ++r) ps += p0[r];
#pragma unroll
    for (int r = 0; r < 16; ++r) ps += p1[r];
    { auto rr = __builtin_amdgcn_permlane32_swap(__float_as_uint(ps), __float_as_uint(ps), false, false);
      ps = __uint_as_float(rr[0]) + __uint_as_float(rr[1]); }
    l_reg += ps;
#define PK4(P, B_, OUT) do { unsigned a0 = cvtpk(P[B_+0], P[B_+1]), a1 = cvtpk(P[B_+2], P[B_+3]);                          \
        unsigned b0 = cvtpk(P[B_+4], P[B_+5]), b1 = cvtpk(P[B_+6], P[B_+7]);                                             \
        auto r0 = __builtin_amdgcn_permlane32_swap(a0, b0, false, false); auto r1 = __builtin_amdgcn_permlane32_swap(a1, b1, false, false); \
        u32x4 w = {r0[0], r1[0], r0[1], r1[1]}; OUT = *reinterpret_cast<bf16x8*>(&w); } while (0)
    PK4(p0, 0, pa0); PK4(p0, 8, pa1); PK4(p1, 0, pa2); PK4(p1, 8, pa3);
#undef PK4
}
template <bool SK>
__device__ __forceinline__ void qkt(f32x16& p0, f32x16& p1, const char* K_lds, int r32, int hi, const bf16x8* qr, bool act, float binit) {
    if (SK && !act) { const float NEG = -__builtin_inff();
#pragma unroll
        for (int r = 0; r < 16; ++r) { p0[r] = NEG; p1[r] = NEG; } return; }
#pragma unroll
    for (int r = 0; r < 16; ++r) { p0[r] = binit; p1[r] = binit; }
    const char* kb[4];
#pragma unroll
    for (int dd = 0; dd < 4; ++dd) kb[dd] = K_lds + KSWZ(r32, (dd * 16 + hi * 8) * 2);
#pragma unroll
    for (int d0 = 0; d0 < 8; ++d0) { const char* a = kb[d0 & 3] + (d0 >> 2) * 128;
        bf16x8 b0 = *reinterpret_cast<const bf16x8*>(a);
        bf16x8 b1 = *reinterpret_cast<const bf16x8*>(a + 32 * 256);
        p0 = __builtin_amdgcn_mfma_f32_32x32x16_bf16(b0, qr[d0], p0, 0, 0, 0);
        p1 = __builtin_amdgcn_mfma_f32_32x32x16_bf16(b1, qr[d0], p1, 0, 0, 0); }
}
template <bool SK>
__device__ __forceinline__ void pv_tile(f32x16* o, int vb0, bf16x8 pa0, bf16x8 pa1, bf16x8 pa2, bf16x8 pa3, bool act) {
    if (SK && !act) return;
#define TRRD(dst, off) asm volatile("ds_read_b64_tr_b16 %0, %1 offset:%2" : "=&v"(dst) : "v"(vb0), "i"(off) : "memory")
#define PV_D0(d0) do { s16x4 l0, l1, l2, l3, h0, h1, h2, h3; constexpr int b_ = v_rd_off(d0, 0, 0); \
        TRRD(l0, b_); TRRD(h0, b_ + 2048); TRRD(l1, b_ + 4096); TRRD(h1, b_ + 6144); TRRD(l2, b_ + 8192); TRRD(h2, b_ + 10240); TRRD(l3, b_ + 12288); TRRD(h3, b_ + 14336); \
        asm volatile("s_waitcnt lgkmcnt(0)" ::: "memory"); SBAR();   \
        o[d0] = __builtin_amdgcn_mfma_f32_32x32x16_bf16(pa0, (bf16x8){l0[0], l0[1], l0[2], l0[3], h0[0], h0[1], h0[2], h0[3]}, o[d0], 0, 0, 0);   \
        o[d0] = __builtin_amdgcn_mfma_f32_32x32x16_bf16(pa1, (bf16x8){l1[0], l1[1], l1[2], l1[3], h1[0], h1[1], h1[2], h1[3]}, o[d0], 0, 0, 0);   \
        o[d0] = __builtin_amdgcn_mfma_f32_32x32x16_bf16(pa2, (bf16x8){l2[0], l2[1], l2[2], l2[3], h2[0], h2[1], h2[2], h2[3]}, o[d0], 0, 0, 0);   \
        o[d0] = __builtin_amdgcn_mfma_f32_32x32x16_bf16(pa3, (bf16x8){l3[0], l3[1], l3[2], l3[3], h3[0], h3[1], h3[2], h3[3]}, o[d0], 0, 0, 0); } while (0)
    PV_D0(0); PV_D0(1); PV_D0(2); PV_D0(3);
#undef PV_D0
#undef TRRD
}
__device__ __forceinline__ void pv256(f32x16* o, int vb0, bf16x8 pa0, bf16x8 pa1, bf16x8 pa2, bf16x8 pa3) {
#define TRRD(dst, off) asm volatile("ds_read_b64_tr_b16 %0, %1 offset:%2" : "=&v"(dst) : "v"(vb0), "i"(off) : "memory")
#define RD8(S, d) do { constexpr int b_ = ((d) >> 2) * 16384 + v_rd_off((d) & 3, 0, 0); \
        TRRD(S##l0, b_); TRRD(S##h0, b_ + 2048); TRRD(S##l1, b_ + 4096); TRRD(S##h1, b_ + 6144); TRRD(S##l2, b_ + 8192); TRRD(S##h2, b_ + 10240); TRRD(S##l3, b_ + 12288); TRRD(S##h3, b_ + 14336); } while (0)
#define MM4(S, d) do { \
        o[d] = __builtin_amdgcn_mfma_f32_32x32x16_bf16(pa0, (bf16x8){S##l0[0], S##l0[1], S##l0[2], S##l0[3], S##h0[0], S##h0[1], S##h0[2], S##h0[3]}, o[d], 0, 0, 0);   \
        o[d] = __builtin_amdgcn_mfma_f32_32x32x16_bf16(pa1, (bf16x8){S##l1[0], S##l1[1], S##l1[2], S##l1[3], S##h1[0], S##h1[1], S##h1[2], S##h1[3]}, o[d], 0, 0, 0);   \
        o[d] = __builtin_amdgcn_mfma_f32_32x32x16_bf16(pa2, (bf16x8){S##l2[0], S##l2[1], S##l2[2], S##l2[3], S##h2[0], S##h2[1], S##h2[2], S##h2[3]}, o[d], 0, 0, 0);   \
        o[d] = __builtin_amdgcn_mfma_f32_32x32x16_bf16(pa3, (bf16x8){S##l3[0], S##l3[1], S##l3[2], S##l3[3], S##h3[0], S##h3[1], S##h3[2], S##h3[3]}, o[d], 0, 0, 0); } while (0)
#define WAITL(n) do { asm volatile("s_waitcnt lgkmcnt(" #n ")" ::: "memory"); SBAR(); } while (0)
    s16x4 Al0, Al1, Al2, Al3, Ah0, Ah1, Ah2, Ah3, Bl0, Bl1, Bl2, Bl3, Bh0, Bh1, Bh2, Bh3;
    RD8(A, 0);
    RD8(B, 1); WAITL(8); MM4(A, 0);
    RD8(A, 2); WAITL(8); MM4(B, 1);
    RD8(B, 3); WAITL(8); MM4(A, 2);
    RD8(A, 4); WAITL(8); MM4(B, 3);
    RD8(B, 5); WAITL(8); MM4(A, 4);
    RD8(A, 6); WAITL(8); MM4(B, 5);
    RD8(B, 7); WAITL(8); MM4(A, 6);
    WAITL(0); MM4(B, 7);
#undef TRRD
#undef RD8
#undef MM4
#undef WAITL
}
typedef __amdgpu_buffer_rsrc_t rsrc_t;
#define LASV __attribute__((address_space(3))) void
__device__ __forceinline__ bf16x8 bload8(rsrc_t rs, unsigned voff, unsigned soff) { return __builtin_bit_cast(bf16x8, __builtin_amdgcn_raw_buffer_load_b128(rs, voff, soff, 0)); }
struct BlockRef { unsigned Q, K, V; bf16* O; int P0; int map; float sink2; };
struct Seam { bf16x8 qr[8]; int slot; };
struct Stg { unsigned k0, k1, v0, v1; };
__device__ __forceinline__ int swa_jlo(int P0, int W) { const int lowk = P0 - W + 1; return lowk > 0 ? lowk / KVBLK : 0; }
#define LASU __attribute__((address_space(3))) unsigned
#define VMW() asm volatile("s_waitcnt vmcnt(0)" ::: "memory")
#define VMWN(n) asm volatile("s_waitcnt vmcnt(%0)" :: "i"(n) : "memory")
template <int LDQK>
__device__ __forceinline__ Stg make_stg(int wid, int lane) {
    Stg g;
    { const int s = wid * 2, row = s * 4 + (lane >> 4), cc = lane & 15; g.k0 = (unsigned)(row * LDQK + ((cc ^ (row & 7)) * 8)) * 2u; }
    { const int s = wid * 2 + 1, row = s * 4 + (lane >> 4), cc = lane & 15; g.k1 = (unsigned)(row * LDQK + ((cc ^ (row & 7)) * 8)) * 2u; }
    { const int s = wid * 2, kk = (s >> 1) * 8 + ((lane >> 2) & 7), c = ((s & 1) * 2 + (lane >> 5)) * 32 + (lane & 3) * 8, k = (kk & ~0xC) | ((kk & 4) << 1) | ((kk & 8) >> 1); g.v0 = (unsigned)(k * LDQK + c) * 2u; }
    { const int s = wid * 2 + 1, kk = (s >> 1) * 8 + ((lane >> 2) & 7), c = ((s & 1) * 2 + (lane >> 5)) * 32 + (lane & 3) * 8, k = (kk & ~0xC) | ((kk & 4) << 1) | ((kk & 8) >> 1); g.v1 = (unsigned)(k * LDQK + c) * 2u; }
    return g;
}
template <int LDQK>
__device__ __forceinline__ void dma_tile(rsrc_t rs, unsigned Kh, unsigned Vh, int kbase, int slot, char* lds, int wid, const Stg& g) {
    const unsigned ko = Kh + (unsigned)kbase * (LDQK * 2u), vo = Vh + (unsigned)kbase * (LDQK * 2u);
    char* kd = lds + 3 * SHM_V + slot * SHM_K + wid * 2048; char* vd = lds + slot * SHM_V + wid * 2048;
    __builtin_amdgcn_raw_ptr_buffer_load_lds(rs, (LASV*)kd, 16, g.k0, ko, 0, 0);
    __builtin_amdgcn_raw_ptr_buffer_load_lds(rs, (LASV*)(kd + 1024), 16, g.k1, ko, 0, 0);
    __builtin_amdgcn_raw_ptr_buffer_load_lds(rs, (LASV*)vd, 16, g.v0, vo, 0, 0);
    __builtin_amdgcn_raw_ptr_buffer_load_lds(rs, (LASV*)(vd + 1024), 16, g.v1, vo, 0, 0);
}
template <int LDQK>
__device__ __forceinline__ void attn_prime(rsrc_t rs, const BlockRef& cur, int W, char* lds, Seam& S, const Stg& g, int tid) {
    const int wid = __builtin_amdgcn_readfirstlane(tid >> 6), lane = tid & 63, r32 = lane & 31, hi = lane >> 5;
    S.slot = 0;
    dma_tile<LDQK>(rs, cur.K, cur.V, swa_jlo(cur.P0, W) * KVBLK, 0, lds, wid, g);
#pragma unroll
    for (int d0 = 0; d0 < 8; ++d0) S.qr[d0] = bload8(rs, (unsigned)((wid * QBLK + r32) * LDQK + hi * 8) * 2u + d0 * 32, cur.Q);
    VMW(); __syncthreads();
}
template <int LDQK, int LDO>
__device__ __forceinline__ void attn_block(rsrc_t rs, const BlockRef& cur, const BlockRef& nxt, int skv, int W, char* lds, Seam& S, const Stg& g, int tid) {
    constexpr bool SK = true;
    const int wid = __builtin_amdgcn_readfirstlane(tid >> 6), lane = tid & 63, r32 = lane & 31, hi = lane >> 5;
    const int j_lo = swa_jlo(cur.P0, W);
    int j_hi = (cur.P0 + QB - 1) / KVBLK + 1; if (j_hi > skv / KVBLK) j_hi = skv / KVBLK;
    const int NT = j_hi - j_lo;
    const int kbn = swa_jlo(nxt.P0, W) * KVBLK;
    const int qlo = cur.P0 + wid * QBLK, qm = qlo + r32 - 4 * hi;
    char* V_lds = lds; char* K_lds = lds + 3 * SHM_V;
    float* ws = (float*)(lds + LDS_WS) + wid * 64; float* li_l = ws; const float* bnd = (const float*)(lds + LDS_BND);
    const float* lut = (const float*)(lds + LDS_LUT) + cur.map * LUTS;
    const float cfar = __builtin_bit_cast(float, __builtin_amdgcn_readfirstlane(__builtin_bit_cast(int, lut[127])));
    float l_reg = 0; f32x16 o[4] = {};
    const int vb0 = (int)(uintptr_t)V_lds + v_rd_base(lane);
    const unsigned Kh = cur.K, Vh = cur.V;
    int sl = S.slot;
#define NEXT(s) ((s) == 2 ? 0 : (s) + 1)
#define PREV(s) ((s) == 0 ? 2 : (s) - 1)
#define KBASE(t) ((j_lo + (t)) * KVBLK)
#define ACT(t) (KBASE(t) <= qlo + QBLK - 1 && KBASE(t) + KVBLK - 1 >= qlo - W + 1)
#define FIX(t) (KBASE(t) + KVBLK + 126 > qlo || KBASE(t) <= qlo + QBLK - 1 - W)
#define BINIT(t) (FIX(t) ? 0.f : cfar)
#define MASKT(P0_, P1_, t) do { const int kb_ = KBASE(t); if ((!SK || ACT(t)) && FIX(t)) bias_mask_tile(P0_, P1_, qm - kb_, (unsigned)W, lut); } while (0)
    f32x16 pA0, pA1, pB0, pB1; bf16x8 pa0, pa1, pa2, pa3;
    if (NT > 1) dma_tile<LDQK>(rs, Kh, Vh, KBASE(1), NEXT(sl), lds, wid, g);
    SBAR(); qkt<SK>(pA0, pA1, K_lds + sl * SHM_K, r32, hi, S.qr, ACT(0), BINIT(0));
    MASKT(pA0, pA1, 0); partialSM(pA0);
    VMW(); __syncthreads();
    sl = NEXT(sl);
#define HALF_STEP(PX0, PX1, PY0, PY1, t) do {                                                                  \
        if ((t) + 1 < NT) dma_tile<LDQK>(rs, Kh, Vh, KBASE((t) + 1), NEXT(sl), lds, wid, g);                                      \
        SBAR(); qkt<SK>(PX0, PX1, K_lds + sl * SHM_K, r32, hi, S.qr, ACT(t), BINIT(t));                                       \
        finishSM(PY0, PY1, l_reg, pa0, pa1, pa2, pa3); SBAR();                                                                \
        pv_tile<SK>(o, vb0 + PREV(sl) * SHM_V, pa0, pa1, pa2, pa3, ACT((t) - 1)); MASKT(PX0, PX1, (t)); partialSM(PX0); \
        VMW(); __syncthreads();                                                                                               \
        sl = NEXT(sl); } while (0)
    int t = 1;
    for (; t + 1 < NT; t += 2) {
        HALF_STEP(pB0, pB1, pA0, pA1, t);
        HALF_STEP(pA0, pA1, pB0, pB1, t + 1);
    }
    const bool even = (NT & 1) == 0;
    if (even) { SBAR(); qkt<SK>(pB0, pB1, K_lds + sl * SHM_K, r32, hi, S.qr, ACT(NT - 1), BINIT(NT - 1)); SBAR(); sl = NEXT(sl); }
    dma_tile<LDQK>(rs, nxt.K, nxt.V, kbn, sl, lds, wid, g); SBAR();
#pragma unroll
    for (int d0 = 0; d0 < 8; ++d0) S.qr[d0] = bload8(rs, (unsigned)((wid * QBLK + r32) * LDQK + hi * 8) * 2u + d0 * 32, nxt.Q);
    SBAR();
    S.slot = sl;
    finishSM(pA0, pA1, l_reg, pa0, pa1, pa2, pa3); SBAR();
    pv_tile<SK>(o, vb0 + (even ? PREV(PREV(sl)) : PREV(sl)) * SHM_V, pa0, pa1, pa2, pa3, ACT(even ? NT - 2 : NT - 1));
    if (even) { MASKT(pB0, pB1, NT - 1); partialSM(pB0);
        finishSM(pB0, pB1, l_reg, pa0, pa1, pa2, pa3); SBAR(); pv_tile<SK>(o, vb0 + PREV(sl) * SHM_V, pa0, pa1, pa2, pa3, ACT(NT - 1)); }
    SBAR(); VMWN(8); SBAR();
    if (hi == 0) li_l[r32] = l_reg + __builtin_amdgcn_exp2f(cur.sink2 - bnd[cur.map]);
    asm volatile("s_waitcnt lgkmcnt(0)" ::: "memory");
    float rli[16];
#pragma unroll
    for (int r = 0; r < 16; ++r) rli[r] = __builtin_amdgcn_rcpf(li_l[crow(r, hi)]);
    bf16* Ow = cur.O + (size_t)(wid * QBLK) * LDO;
#pragma unroll
    for (int r = 0; r < 16; ++r) { const int orow = crow(r, hi);
#pragma unroll
        for (int d0 = 0; d0 < 4; ++d0) { const float v = o[d0][r] * rli[r];
            const float vn = shflx(v, 1, lane);
            if ((r32 & 1) == 0) *(unsigned*)(Ow + (size_t)orow * LDO + d0 * 32 + r32) = cvtpk(v, vn); } }
    __syncthreads();
#undef KBASE
#undef ACT
#undef FIX
#undef BINIT
#undef MASKT
#undef HALF_STEP
#undef NEXT
#undef PREV
}
#undef VMW
#undef VMWN
#undef LASU

struct Block2 { unsigned Q, K, V; bf16* O; int P0; int map0; int rev; };
struct Seam2 { bf16x8 qr[8]; int st; };
constexpr int ST2 = 65536;
#define LASU __attribute__((address_space(3))) unsigned
#define VMW() asm volatile("s_waitcnt vmcnt(0)" ::: "memory")
#define VMWN(n) asm volatile("s_waitcnt vmcnt(%0)" :: "i"(n) : "memory")
template <int LD>
__device__ __forceinline__ void dma_k2(rsrc_t rs, unsigned Kb, int kbase, int st, char* lds, int wid, const Stg& g) {
    const unsigned so = Kb + (unsigned)kbase * (LD * 2u); char* d = lds + st * ST2 + wid * 2048;
    __builtin_amdgcn_raw_ptr_buffer_load_lds(rs, (LASV*)d, 16, g.k0, so, 0, 0);
    __builtin_amdgcn_raw_ptr_buffer_load_lds(rs, (LASV*)(d + 1024), 16, g.k1, so, 0, 0);
    __builtin_amdgcn_raw_ptr_buffer_load_lds(rs, (LASV*)(d + 16384), 16, g.k0, so + 256u, 0, 0);
    __builtin_amdgcn_raw_ptr_buffer_load_lds(rs, (LASV*)(d + 16384 + 1024), 16, g.k1, so + 256u, 0, 0);
}
template <int LD>
__device__ __forceinline__ void dma_v2(rsrc_t rs, unsigned Vb, int kbase, int st, char* lds, int wid, const Stg& g) {
    const unsigned so = Vb + (unsigned)kbase * (LD * 2u); char* d = lds + st * ST2 + wid * 2048;
    __builtin_amdgcn_raw_ptr_buffer_load_lds(rs, (LASV*)(d + 32768), 16, g.v0, so, 0, 0);
    __builtin_amdgcn_raw_ptr_buffer_load_lds(rs, (LASV*)(d + 32768 + 1024), 16, g.v1, so, 0, 0);
    __builtin_amdgcn_raw_ptr_buffer_load_lds(rs, (LASV*)(d + 49152), 16, g.v0, so + 256u, 0, 0);
    __builtin_amdgcn_raw_ptr_buffer_load_lds(rs, (LASV*)(d + 49152 + 1024), 16, g.v1, so + 256u, 0, 0);
}
template <int LD>
__device__ __forceinline__ void attn2_prime(rsrc_t rs, const Block2& cur, char* lds, Seam2& S, const Stg& g, int tid) {
    const int wid = __builtin_amdgcn_readfirstlane(tid >> 6), lane = tid & 63, r32 = lane & 31, hi = lane >> 5, ms = wid >> 2, rg = wid & 3;
    S.st = 0;
    const int ft = cur.rev ? (cur.P0 + 127) / KVBLK : 0;
    dma_k2<LD>(rs, cur.K, ft * KVBLK, 0, lds, wid, g); dma_v2<LD>(rs, cur.V, ft * KVBLK, 0, lds, wid, g);
    const unsigned ql = (unsigned)((rg * QBLK + r32) * LD + ms * 128 + hi * 8) * 2u;
#pragma unroll
    for (int d0 = 0; d0 < 8; ++d0) S.qr[d0] = bload8(rs, ql + d0 * 32, cur.Q);
    VMW(); __syncthreads();
}
template <int LD, int LDO, class RefFn>
__device__ __forceinline__ int attn2_block(rsrc_t rs, const Block2& cur, unsigned* qctr, volatile __attribute__((address_space(3))) unsigned* slot, int QN, RefFn ref, char* lds, Seam2& S, const Stg& g, int tid, float lam, const float* g_sub, float osc, float eps) {
    const int wid = __builtin_amdgcn_readfirstlane(tid >> 6), lane = tid & 63, ms = wid >> 2, rg = wid & 3;
    float l_reg = 0; f32x16 o[8] = {}; bf16x8 pa0, pa1, pa2, pa3;
    int st = S.st;
    Block2 nxt = cur; int jnx = QN;
    {
    const int r32 = lane & 31, hi = lane >> 5;
    const int NT = (cur.P0 + 127) / KVBLK + 1;
    const int tbase = cur.rev ? NT - 1 : 0, tstep = cur.rev ? -1 : 1; int nft = 0;
    const int qlo = cur.P0 + rg * QBLK, qm = qlo + r32 - 4 * hi;
    const float* lut = (const float*)(lds + LDS_LUT) + (cur.map0 + ms) * LUTS;
    const float cfar = __builtin_bit_cast(float, __builtin_amdgcn_readfirstlane(__builtin_bit_cast(int, lut[127])));
    const int s0 = st;
#define ISSUE_K(tt) do { if ((tt) < NT) dma_k2<LD>(rs, cur.K, (tbase + (tt) * tstep) * KVBLK, (s0 + (tt)) & 1, lds, wid, g); else dma_k2<LD>(rs, nxt.K, nft * KVBLK, (s0 + (tt)) & 1, lds, wid, g); } while (0)
#define ISSUE_V(tt) do { if ((tt) < NT) dma_v2<LD>(rs, cur.V, (tbase + (tt) * tstep) * KVBLK, (s0 + (tt)) & 1, lds, wid, g); else dma_v2<LD>(rs, nxt.V, nft * KVBLK, (s0 + (tt)) & 1, lds, wid, g); } while (0)
#define LOAD_NEXT_Q() do { SBAR(); const unsigned ql = (unsigned)((rg * QBLK + r32) * LD + ms * 128 + hi * 8) * 2u; _Pragma("unroll") for (int d0 = 0; d0 < 8; ++d0) S.qr[d0] = bload8(rs, ql + d0 * 32, nxt.Q); SBAR(); } while (0)
#define QKT_SM(t) do { const int sg = (s0 + (t)) & 1, kb = (tbase + (t) * tstep) * KVBLK; const bool fix = kb + KVBLK + 126 > qlo;     \
        int lx = lane; asm volatile("" : "+v"(lx)); const int r32x = lx & 31, hix = lx >> 5;     \
        f32x16 p0, p1; SBAR(); __builtin_amdgcn_s_setprio(2); qkt<false>(p0, p1, lds + sg * ST2 + ms * 16384, r32x, hix, S.qr, true, fix ? 0.f : cfar);     \
        if (fix) bias_mask_tile(p0, p1, qlo + r32x - 4 * hix - kb, 1u << 30, lut); \
        partialSM(p0); finishSM(p0, p1, l_reg, pa0, pa1, pa2, pa3); __builtin_amdgcn_s_setprio(0); SBAR(); } while (0)
#define PV(t) do { int lx = lane; asm volatile("" : "+v"(lx)); const int vb = (int)(uintptr_t)(lds + ((s0 + (t)) & 1) * ST2 + 32768) + v_rd_base(lx); SBAR(); \
        pv256(o, vb, pa0, pa1, pa2, pa3); SBAR(); } while (0)
#define HS_END(all) do { if (all) asm volatile("s_waitcnt vmcnt(0) lgkmcnt(0)" ::: "memory"); else asm volatile("s_waitcnt vmcnt(4) lgkmcnt(0)" ::: "memory"); \
        __builtin_amdgcn_s_barrier(); asm volatile("" ::: "memory"); } while (0)
#define FETCH_NEXT() do { jnx = __builtin_amdgcn_readfirstlane((int)*slot); if (jnx < QN) { ref(jnx, nxt); nft = nxt.rev ? (nxt.P0 + 127) / KVBLK : 0; } } while (0)
    if (ms == 0) {
#pragma nounroll
        for (int t = 0; t < NT; ++t) { const bool lastt = t + 1 == NT, claim = t + 2 == NT;
            if (lastt) FETCH_NEXT();
            ISSUE_K(t + 1); QKT_SM(t); HS_END(false);
            unsigned gq = 0;
            if (claim && tid == 0) gq = __hip_atomic_fetch_add(qctr, 1u, __ATOMIC_RELAXED, __HIP_MEMORY_SCOPE_AGENT);
            ISSUE_V(t + 1); PV(t);
            if (claim) { VMWN(4); if (tid == 0) *slot = gq; }
            HS_END(lastt); }
        HS_END(true);
    } else {
        ISSUE_K(1); HS_END(false);
#pragma nounroll
        for (int t = 0; t < NT; ++t) { const bool lastt = t + 1 == NT;
            ISSUE_V(t + 1); QKT_SM(t); HS_END(lastt);
            if (!lastt) { if (t + 2 == NT) FETCH_NEXT(); ISSUE_K(t + 2); }
            PV(t); HS_END(lastt); }
    }
#undef FETCH_NEXT
    LOAD_NEXT_Q();
#undef ISSUE_K
#undef ISSUE_V
#undef LOAD_NEXT_Q
#undef QKT_SM
#undef PV
#undef HS_END
    st = (s0 + NT) & 1;
    }
    S.st = st;
    int lane_e = lane; asm volatile("" : "+v"(lane_e));
    const int r32 = lane_e & 31, hi = lane_e >> 5;
    float* li_l = (float*)(lds + LDS_WS) + wid * 64;
    if (hi == 0) li_l[r32] = l_reg;
    asm volatile("s_waitcnt lgkmcnt(0)" ::: "memory");
    unsigned short* xr = (unsigned short*)(lds + (st ^ 1) * ST2 + rg * 16384);
    if (ms == 1) {
#pragma unroll
        for (int r = 0; r < 16; ++r) { const int row = crow(r, hi); const float f = __builtin_amdgcn_rcpf(li_l[row]) * lam;
#pragma unroll
            for (int d0 = 0; d0 < 8; ++d0) xr[row * 256 + d0 * 32 + r32] = (unsigned short)cvtpk(o[d0][r] * f, 0.f);
            if ((r & 3) == 3) asm volatile("" ::: "memory"); }
    }
    asm volatile("s_waitcnt lgkmcnt(0)" ::: "memory");
    __syncthreads();
    if (ms == 0) {
        float gs[8];
#pragma unroll
        for (int d0 = 0; d0 < 8; ++d0) gs[d0] = g_sub[d0 * 32 + r32] * osc;
        float rlv[16], av[16];
#pragma unroll
        for (int r = 0; r < 16; ++r) rlv[r] = __builtin_amdgcn_rcpf(li_l[crow(r, hi)]);
#pragma unroll
        for (int r = 0; r < 16; ++r) { const int row = crow(r, hi); float a = 0.f;
#pragma unroll
            for (int d0 = 0; d0 < 8; ++d0) { const float x2 = __uint_as_float((unsigned)xr[row * 256 + d0 * 32 + r32] << 16); const float v = o[d0][r] * rlv[r] - x2; a += v * v; }
            av[r] = sum16(a); }
#pragma unroll
        for (int r = 0; r < 16; ++r) av[r] += swz16(av[r]);
#pragma unroll
        for (int r = 0; r < 16; ++r) av[r] = __builtin_amdgcn_rsqf(av[r] * (1.f / 256.f) + eps);
#pragma unroll
        for (int r = 0; r < 16; ++r) { const int row = crow(r, hi);
#pragma unroll
            for (int d0 = 0; d0 < 8; ++d0) { const float x2 = __uint_as_float((unsigned)xr[row * 256 + d0 * 32 + r32] << 16);
                xr[row * 256 + d0 * 32 + r32] = (unsigned short)cvtpk((o[d0][r] * rlv[r] - x2) * av[r] * gs[d0], 0.f); }
            if ((r & 3) == 3) asm volatile("" ::: "memory"); }
        asm volatile("s_waitcnt lgkmcnt(0)" ::: "memory");
        bf16* Ow = cur.O + (size_t)(rg * QBLK) * LDO;
#pragma unroll
        for (int j = 0; j < 16; ++j) { const int c = lane_e + 64 * j, row = c >> 5, cc = c & 31;
            *(u32x4*)(Ow + (size_t)row * LDO + cc * 8) = *(const u32x4*)(xr + row * 256 + cc * 8); }
    }
    __syncthreads();
    return jnx;
}
#undef VMW
#undef VMWN
#undef LASU
#undef LASV
}
constexpr int NWAVES = 8;
constexpr int BATCH = 2, SEQ = 8192, DM = 4096, M = BATCH * SEQ;
constexpr int DFF = 11008, NQKV = 3 * DM, NGU = 2 * DFF, NKVQ = 2048 + DM;
constexpr float EPS = 1e-6f, LOG2E = 1.4426950408889634f, QSCALE = 0.08838834764831845f * LOG2E;
constexpr float LAMBDA_INIT = 0.2f;
__device__ const unsigned char T5_BUCKET[128] = {0, 1, 2, 3, 4, 5, 6, 7, 8, 9, 10, 11, 12, 13, 14, 15, 16, 16, 16, 17, 17, 18, 18, 18, 19, 19, 19, 20, 20, 20, 20, 21, 21, 21, 21, 22, 22, 22, 22, 22, 23, 23, 23, 23, 23, 23, 24, 24, 24, 24, 24, 24, 25, 25, 25, 25, 25, 25, 25, 26, 26, 26, 26, 26, 26, 26, 26, 27, 27, 27, 27, 27, 27, 27, 27, 27, 27, 28, 28, 28, 28, 28, 28, 28, 28, 28, 28, 29, 29, 29, 29, 29, 29, 29, 29, 29, 29, 29, 29, 30, 30, 30, 30, 30, 30, 30, 30, 30, 30, 30, 30, 30, 30, 31, 31, 31, 31, 31, 31, 31, 31, 31, 31, 31, 31, 31, 31, 31};
constexpr size_t MiB = 1u << 20;
constexpr size_t WS_CTL = 0, CTL_ZERO_BYTES = 1 * MiB;
constexpr size_t SZ_WQKV = (size_t)NQKV * DM * 2, SZ_WSQ = (size_t)DM * DM * 2, SZ_WGU = (size_t)NGU * DM * 2, SZ_WD = (size_t)DM * DFF * 2, SZ_WKVQ = (size_t)NKVQ * DM * 2;
constexpr size_t WS_WQKV = 1 * MiB, WS_WOA = WS_WQKV + SZ_WQKV, WS_WGU0 = WS_WOA + SZ_WSQ, WS_WD0 = WS_WGU0 + SZ_WGU, WS_WKVQ = WS_WD0 + SZ_WD, WS_WOB = WS_WKVQ + SZ_WKVQ,
                 WS_WGU1 = WS_WOB + SZ_WSQ, WS_WD1 = WS_WGU1 + SZ_WGU, WS_WEND = WS_WD1 + SZ_WD;
constexpr size_t WS_H = WS_WEND;
constexpr size_t WS_R1 = WS_H + (size_t)M * DM * 2;
constexpr size_t WS_R2 = WS_R1 + (size_t)M * NQKV * 2;
constexpr size_t WS_XB = WS_R2 + (size_t)M * 8192 * 2;
constexpr size_t WS_END = WS_XB + (size_t)M * DM * 2;
constexpr size_t WS_SS = 262144;
constexpr int CW_TMO = 0, CW_CODE = 1, CW_BAR = 4096, CW_QUEUE = 8192, CW_MAPBAD = 9000;
#ifndef NCONV
#define NCONV 4
#endif
constexpr int RING_OFF = 0, RING_BYTES = 131072;
constexpr int LDSCTL_OFF = RING_BYTES, MISC_OFF = LDSCTL_OFF + 320;
constexpr int LDS_BYTES = 154624;
static_assert(att::LDS_BYTES <= LDS_BYTES && MISC_OFF + 128 <= att::LDS_WS, "LDS map");
#define GAS __attribute__((address_space(1)))
#define LAS __attribute__((address_space(3)))
typedef unsigned short bf16;
typedef unsigned v4u __attribute__((ext_vector_type(4)));
typedef float f32x4 __attribute__((ext_vector_type(4)));
typedef short bf16x8 __attribute__((ext_vector_type(8)));
typedef GAS unsigned gu32;
typedef GAS unsigned long long gu64;
#define RLX_AGENT __ATOMIC_RELAXED, __HIP_MEMORY_SCOPE_AGENT
#define LDS_WAIT() asm volatile("s_waitcnt lgkmcnt(0)" ::: "memory")
#define VM_WAIT() asm volatile("s_waitcnt vmcnt(0)" ::: "memory")
__device__ __forceinline__ unsigned long long rt() { return __builtin_amdgcn_s_memrealtime(); }
__device__ __forceinline__ unsigned f2bf(float f) { unsigned u = __builtin_bit_cast(unsigned, f); return (u + 0x7fffu + ((u >> 16) & 1u)) >> 16; }
__device__ __forceinline__ unsigned pk2(float lo, float hi) { unsigned r; asm("v_cvt_pk_bf16_f32 %0, %1, %2" : "=v"(r) : "v"(lo), "v"(hi)); return r; }

#define XB_TMO      128
#define XB_XCNT(j)  (256  + 64 * (j))
#define XB_XSUB(j)  (1280 + 64 * (j))
#define XB_XGEN(j)  (2304 + 64 * (j))
#define XB_TOP      3328
#define XB_TOPGEN   3392
#define XCD_BAR_WORDS 3456
#define XB_SPIN_CAP (1u << 18)

__device__ __forceinline__ unsigned xb_ld(unsigned* p)              { return __hip_atomic_load(p, __ATOMIC_RELAXED, __HIP_MEMORY_SCOPE_AGENT); }
__device__ __forceinline__ unsigned xb_add(unsigned* p, unsigned v) { return __hip_atomic_fetch_add(p, v, __ATOMIC_RELAXED, __HIP_MEMORY_SCOPE_AGENT); }
__device__ __forceinline__ unsigned xb_xcc_id() { return (unsigned)__builtin_amdgcn_s_getreg((3 << 11) | 20) & 0xFu; }
#define XB_SPIN(cond, bar) do { unsigned _sp = 0; while (cond) { __builtin_amdgcn_s_sleep(1); \
    if ((++_sp & 255u) == 0u) { if (xb_ld(&(bar)[XB_TMO])) break; if (_sp > XB_SPIN_CAP) { atomicAdd(&(bar)[XB_TMO], 1u); break; } } } } while (0)

struct XcdBarrier {
    unsigned* bar; unsigned x;
    volatile LAS unsigned* st;
};

__device__ __forceinline__ XcdBarrier xcd_barrier_post(unsigned* bar, volatile LAS unsigned* st) {
    XcdBarrier b; b.bar = bar; b.x = xb_xcc_id(); b.st = st;
    if (threadIdx.x == 0) (void)xb_add(&bar[XB_XCNT(b.x)], 1u);
    return b;
}
__device__ __forceinline__ void xcd_barrier_complete(unsigned* bar, unsigned x, unsigned& nloc, unsigned& nx) {
    const unsigned G = gridDim.x * gridDim.y * gridDim.z;
    unsigned sum, cnt, mine, sp = 0u;
    for (;;) {
        sum = 0u; cnt = 0u; mine = 0u;
#pragma unroll
        for (unsigned j = 0; j < 16; ++j) { const unsigned c = xb_ld(&bar[XB_XCNT(j)]); sum += c; cnt += (c > 0u) ? 1u : 0u; }
        mine = xb_ld(&bar[XB_XCNT(x)]);
        if (sum == G) break;
        __builtin_amdgcn_s_sleep(1);
        if ((++sp & 255u) == 0u) { if (xb_ld(&bar[XB_TMO])) break; if (sp > XB_SPIN_CAP) { atomicAdd(&bar[XB_TMO], 1u); break; } }
    }
    nloc = mine > 0u ? mine : 1u; nx = cnt > 0u ? cnt : 1u;
}

__device__ __forceinline__ void xcd_barrier(const XcdBarrier& b) {
    asm volatile("s_waitcnt vmcnt(0)" ::: "memory");
    __syncthreads();
    if (threadIdx.x == 0) {
        unsigned* bar = b.bar; asm volatile("" : "+s"(bar));
        __builtin_amdgcn_s_waitcnt(0);
        unsigned nloc = b.st[0], nx = b.st[1];
        if (nloc == 0u) { xcd_barrier_complete(bar, b.x, nloc, nx); b.st[0] = nloc; b.st[1] = nx; }
        const unsigned old = xb_add(&bar[XB_XSUB(b.x)], 1u);
        const unsigned gen = old / nloc;
        if (old + 1u == (gen + 1u) * nloc) {
            __builtin_amdgcn_fence(__ATOMIC_RELEASE, "agent");
            asm volatile("s_waitcnt vmcnt(0)" ::: "memory");
            const unsigned og = xb_add(&bar[XB_TOP], 1u);
            const unsigned tg = og / nx;
            if (og + 1u == (tg + 1u) * nx) xb_add(&bar[XB_TOPGEN], 1u);
            else XB_SPIN(xb_ld(&bar[XB_TOPGEN]) == tg, bar);
            __builtin_amdgcn_fence(__ATOMIC_ACQUIRE, "agent");
            xb_add(&bar[XB_XGEN(b.x)], 1u);
            asm volatile("s_waitcnt vmcnt(0)" ::: "memory");
        } else {
            XB_SPIN(xb_ld(&bar[XB_XGEN(b.x)]) == gen, bar);
            __builtin_amdgcn_fence(__ATOMIC_ACQUIRE, "agent");
            asm volatile("s_waitcnt vmcnt(0)" ::: "memory");
        }
    }
    __syncthreads();
}
__device__ __forceinline__ void xcd_barrier_local(const XcdBarrier& b) {
    asm volatile("s_waitcnt vmcnt(0)" ::: "memory");
    __syncthreads();
    if (threadIdx.x == 0) {
        unsigned* bar = b.bar; asm volatile("" : "+s"(bar));
        __builtin_amdgcn_s_waitcnt(0);
        const unsigned nloc = b.st[0];
        const unsigned old = xb_add(&bar[XB_XSUB(b.x)], 1u);
        const unsigned gen = old / nloc;
        if (old + 1u == (gen + 1u) * nloc) xb_add(&bar[XB_XGEN(b.x)], 1u);
        else XB_SPIN(xb_ld(&bar[XB_XGEN(b.x)]) == gen, bar);
        __builtin_amdgcn_fence(__ATOMIC_ACQUIRE, "agent");
        asm volatile("s_waitcnt vmcnt(0)" ::: "memory");
    }
    __syncthreads();
}
struct Args { const float* in[20]; float* out; unsigned char* ws; };
struct Frame {
    LAS unsigned char* lds; volatile LAS unsigned* MISC; gu32* ctl;
    int tid, lane, wave, vcu, G;
};
__device__ __forceinline__ float wave_sum(float v, int lane) { v = sum16(v); v += swz16(v); v += shflx(v, 32, lane); return v; }
struct TItem { const float* src; bf16* dst; const float* gain; int N, K; };
#define P0_LOAD(T, v) do { _Pragma("unroll") for (int i_ = 0; i_ < 16; ++i_) v[i_] = __builtin_nontemporal_load((const GAS f32x4*)(T.src + (size_t)(8 * (i_ >> 1) + (i_ & 1)) * T.N)); } while (0)
__device__ __forceinline__ void p0_process(const TItem& T, f32x4 (&v)[16], LAS unsigned* scr, int lane) {
    const int q = lane & 15, s = lane >> 4;
    if (T.gain) {
#pragma unroll
        for (int i = 0; i < 16; ++i) { const float g = T.gain[8 * (i >> 1) + 2 * s + (i & 1)]; v[i] = v[i] * g; }
    }
#pragma unroll
    for (int p = 0; p < 8; ++p)
#pragma unroll
        for (int e = 0; e < 4; ++e) scr[(4 * q + e) * 33 + 4 * p + s] = pk2(v[2 * p][e], v[2 * p + 1][e]);
    LDS_WAIT(); asm volatile("" ::: "memory");
    const int c = lane & 7;
#pragma unroll
    for (int j = 0; j < 8; ++j) { const int n = (lane >> 3) + 8 * j; const LAS unsigned* r = scr + n * 33 + 4 * c;
        v4u o; o.x = r[0]; o.y = r[1]; o.z = r[2]; o.w = r[3];
        __builtin_nontemporal_store(o, (GAS v4u*)(T.dst + (size_t)n * T.K + 8 * c)); }
    LDS_WAIT(); asm volatile("" ::: "memory");
}
__device__ __forceinline__ void raw_rows(Frame& F, const float* X, bf16* XB, float* ss) {
    const int gw = F.vcu * NWAVES + F.wave, NGW = F.G * NWAVES;
    for (int m = gw; m < M; m += NGW) {
        const GAS f32x4* xr = (const GAS f32x4*)(X + (size_t)m * DM) + F.lane;
        f32x4 v[16]; float s = 0.f;
#pragma unroll
        for (int j = 0; j < 16; ++j) { v[j] = xr[64 * j]; s += (v[j].x * v[j].x + v[j].y * v[j].y) + (v[j].z * v[j].z + v[j].w * v[j].w); }
        s = wave_sum(s, F.lane);
        if (F.lane == 0) ss[m] = s;
        GAS unsigned long long* o8 = (GAS unsigned long long*)(XB + (size_t)m * DM) + F.lane;
#pragma unroll
        for (int j = 0; j < 16; ++j) o8[64 * j] = (unsigned long long)pk2(v[j].x, v[j].y) | ((unsigned long long)pk2(v[j].z, v[j].w) << 32);
    }
}
__device__ __forceinline__ void head_norm(Frame& F, bf16* T, int ld, int nchunk, int nA, int colA, int colB, const float* gA, float sA, const float* gB, float sB) {
    const int gw = F.vcu * NWAVES + F.wave, NGW = F.G * NWAVES;
    const int d0 = (F.lane & 15) * 8;
    float ga[8], gb[8];
#pragma unroll
    for (int e = 0; e < 8; ++e) { ga[e] = gA[d0 + e] * sA; gb[e] = gB[d0 + e] * sB; }
    const int total = M * nchunk;
    constexpr int U = 8;
    for (int base = gw; base < total; base += NGW * U) {
        v4u w[U]; GAS v4u* p[U]; bool isA[U];
#pragma unroll
        for (int u = 0; u < U; ++u) { int it = base + NGW * u; if (it >= total) it = total - 1; const int m = it / nchunk, c = it - m * nchunk; isA[u] = c < nA;
            p[u] = (GAS v4u*)(T + (size_t)m * ld + (isA[u] ? colA + 512 * c : colB + 512 * (c - nA)) + F.lane * 8); w[u] = *p[u]; }
#pragma unroll
        for (int u = 0; u < U; ++u) {
            float x[8];
            x[0] = __uint_as_float(w[u].x << 16); x[1] = __uint_as_float(w[u].x & 0xffff0000u); x[2] = __uint_as_float(w[u].y << 16); x[3] = __uint_as_float(w[u].y & 0xffff0000u);
            x[4] = __uint_as_float(w[u].z << 16); x[5] = __uint_as_float(w[u].z & 0xffff0000u); x[6] = __uint_as_float(w[u].w << 16); x[7] = __uint_as_float(w[u].w & 0xffff0000u);
            float s = 0.f;
#pragma unroll
            for (int e = 0; e < 8; ++e) s += x[e] * x[e];
            s += shflx(s, 1, F.lane); s += shflx(s, 2, F.lane); s += shflx(s, 4, F.lane); s += shflx(s, 8, F.lane);
            const float rstd = 1.0f / sqrtf(s * (1.f / 128.f) + EPS);
#pragma unroll
            for (int e = 0; e < 8; ++e) x[e] = x[e] * rstd * (isA[u] ? ga[e] : gb[e]);
            v4u o; o.x = pk2(x[0], x[1]); o.y = pk2(x[2], x[3]); o.z = pk2(x[4], x[5]); o.w = pk2(x[6], x[7]);
            if (base + NGW * u < total) *p[u] = o;
        }
    }
}
__device__ __forceinline__ void diff_combine(Frame& F, const bf16* O2, bf16* Oc, const float* lam_qk, const float* g_sub) {
    const int gw = F.vcu * NWAVES + F.wave, NGW = F.G * NWAVES;
    float s1 = lam_qk[F.lane] * lam_qk[128 + F.lane] + lam_qk[64 + F.lane] * lam_qk[192 + F.lane];
    float s2 = lam_qk[256 + F.lane] * lam_qk[384 + F.lane] + lam_qk[320 + F.lane] * lam_qk[448 + F.lane];
    s1 = wave_sum(s1, F.lane); s2 = wave_sum(s2, F.lane);
    const float lam = expf(s1) - expf(s2) + LAMBDA_INIT;
    const int e0 = (F.lane & 31) * 8;
    float gs[8];
#pragma unroll
    for (int e = 0; e < 8; ++e) gs[e] = g_sub[e0 + e] * (1.0f - LAMBDA_INIT);
    const int total = M * 8;
    constexpr int U = 4;
    for (int base = gw; base < total; base += NGW * U) {
        v4u a[U], b[U];
#pragma unroll
        for (int u = 0; u < U; ++u) { int it = base + NGW * u; if (it >= total) it = total - 1; const int m = it >> 3, h = (it & 7) * 2 + (F.lane >> 5);
            const GAS v4u* p1 = (const GAS v4u*)(O2 + (size_t)m * 8192 + (2 * h) * 256 + e0); a[u] = p1[0]; b[u] = p1[32]; }
#pragma unroll
        for (int u = 0; u < U; ++u) { const int it = base + NGW * u; const int m = it >> 3, h = (it & 7) * 2 + (F.lane >> 5);
            float x[8], y[8];
            x[0] = __uint_as_float(a[u].x << 16); x[1] = __uint_as_float(a[u].x & 0xffff0000u); x[2] = __uint_as_float(a[u].y << 16); x[3] = __uint_as_float(a[u].y & 0xffff0000u);
            x[4] = __uint_as_float(a[u].z << 16); x[5] = __uint_as_float(a[u].z & 0xffff0000u); x[6] = __uint_as_float(a[u].w << 16); x[7] = __uint_as_float(a[u].w & 0xffff0000u);
            y[0] = __uint_as_float(b[u].x << 16); y[1] = __uint_as_float(b[u].x & 0xffff0000u); y[2] = __uint_as_float(b[u].y << 16); y[3] = __uint_as_float(b[u].y & 0xffff0000u);
            y[4] = __uint_as_float(b[u].z << 16); y[5] = __uint_as_float(b[u].z & 0xffff0000u); y[6] = __uint_as_float(b[u].w << 16); y[7] = __uint_as_float(b[u].w & 0xffff0000u);
            float s = 0.f;
#pragma unroll
            for (int e = 0; e < 8; ++e) { x[e] = x[e] - lam * y[e]; s += x[e] * x[e]; }
            s += shflx(s, 1, F.lane); s += shflx(s, 2, F.lane); s += shflx(s, 4, F.lane); s += shflx(s, 8, F.lane); s += shflx(s, 16, F.lane);
            const float rstd = 1.0f / sqrtf(s * (1.f / 256.f) + EPS);
#pragma unroll
            for (int e = 0; e < 8; ++e) x[e] = x[e] * rstd * gs[e];
            v4u o; o.x = pk2(x[0], x[1]); o.y = pk2(x[2], x[3]); o.z = pk2(x[4], x[5]); o.w = pk2(x[6], x[7]);
            if (it < total) *(GAS v4u*)(Oc + (size_t)m * DM + h * 256 + e0) = o;
        }
    }
}
__device__ __forceinline__ void fill_lut(Frame& F, const float* rel_bias, const float* gq, const float* gk) {
    LAS float* lut = (LAS float*)(F.lds + RING_OFF + att::LDS_LUT); LAS float* bnd = (LAS float*)(F.lds + RING_OFF + att::LDS_BND);
    float mq = fmaxf(fabsf(gq[F.lane]), fabsf(gq[64 + F.lane])), mk = fmaxf(fabsf(gk[F.lane]), fabsf(gk[64 + F.lane]));
#pragma unroll
    for (int o = 1; o < 64; o <<= 1) { mq = fmaxf(mq, shflx(mq, o, F.lane)); mk = fmaxf(mk, shflx(mk, o, F.lane)); }
    const float bqk = LOG2E * 11.313708498984761f * 1.01f * mq * mk;
    if (F.tid < 32) { float mb = -3.0e38f;
        for (int k = 0; k < 32; ++k) mb = fmaxf(mb, rel_bias[k * 32 + F.tid]);
        bnd[F.tid] = bqk + mb * LOG2E; }
    __syncthreads();
    for (int i = F.tid; i < 32 * 129; i += NWAVES * 64) { const int m = i / 129, d = i - m * 129; lut[m * att::LUTS + d] = d < 128 ? rel_bias[T5_BUCKET[d] * 32 + m] * LOG2E - bnd[m] : -__builtin_inff(); }
    __syncthreads();
}

typedef const __attribute__((address_space(4))) Args* ArgsP;
#define TIDP() do { int t_ = phase_tid(wave_s); asm volatile("" : "+v"(t_)); F.tid = t_; F.lane = t_ & 63; F.wave = __builtin_amdgcn_readfirstlane(t_ >> 6); } while (0)
#define ARGP() ArgsP ap = (ArgsP)__builtin_amdgcn_kernarg_segment_ptr(); asm volatile("" : "+s"(ap))
__device__ __forceinline__ void grid_bar() { ArgsP ap = (ArgsP)__builtin_amdgcn_kernarg_segment_ptr(); asm volatile("" : "+s"(ap));
    XcdBarrier b; b.bar = (unsigned*)(ap->ws + WS_CTL) + CW_BAR; b.x = xb_xcc_id(); b.st = (volatile LAS unsigned*)(MISC_OFF + 32); xcd_barrier(b); }
__device__ __forceinline__ void seam_bar() { ArgsP ap = (ArgsP)__builtin_amdgcn_kernarg_segment_ptr(); asm volatile("" : "+s"(ap));
    XcdBarrier b; b.bar = (unsigned*)(ap->ws + WS_CTL) + CW_BAR; b.x = xb_xcc_id(); b.st = (volatile LAS unsigned*)(MISC_OFF + 32);
    if (*(volatile LAS unsigned*)(MISC_OFF + 68)) xcd_barrier_local(b); else xcd_barrier(b); }

constexpr int I_QKV = (DM / 64) * (NQKV / 64), I_SQ = (DM / 64) * (DM / 64), I_GU = (DM / 64) * (DFF / 64), I_D = (DFF / 64) * (DM / 64), I_KV = (DM / 64) * (2048 / 64);
constexpr int NITEMS = I_QKV + I_SQ + 2 * I_GU + I_D + I_KV + I_SQ + I_SQ + 2 * I_GU + I_D;
#define P0_DECODE(it_, T) do { int r = (it_); const float* W; int K, N; bf16* WT; const float* g; int mode, roff = 0;     \
            if (r < I_QKV) { W = A_w_qkv; K = DM; N = NQKV; WT = A_Wqkv_t; g = A_g_attn; mode = 0; } \
            else if ((r -= I_QKV) < I_SQ) { W = A_w_o_a; K = DM; N = DM; WT = A_Woa_t; g = nullptr; mode = 0; } \
            else if ((r -= I_SQ) < I_GU) { W = A_w_gate; K = DM; N = DFF; WT = A_Wgu0_t; g = A_g_ffn; mode = 1; } \
            else if ((r -= I_GU) < I_GU) { W = A_w_up; K = DM; N = DFF; WT = A_Wgu0_t; g = A_g_ffn; mode = 2; } \
            else if ((r -= I_GU) < I_D) { W = A_w_down; K = DFF; N = DM; WT = A_Wd0_t; g = nullptr; mode = 0; } \
            else if ((r -= I_D) < I_KV) { W = A_w_kv; K = DM; N = 2048; WT = A_Wkvq_t; g = A_g_kvn; mode = 0; } \
            else if ((r -= I_KV) < I_SQ) { W = A_w_q_b; K = DM; N = DM; WT = A_Wkvq_t; g = A_g_attn + DM; mode = 0; roff = 2048; } \
            else if ((r -= I_SQ) < I_SQ) { W = A_w_o_b; K = DM; N = DM; WT = A_Wob_t; g = nullptr; mode = 0; } \
            else if ((r -= I_SQ) < I_GU) { W = A_w_gate + (size_t)DM * DFF; K = DM; N = DFF; WT = A_Wgu1_t; g = A_g_ffn + DM; mode = 1; } \
            else if ((r -= I_GU) < I_GU) { W = A_w_up + (size_t)DM * DFF; K = DM; N = DFF; WT = A_Wgu1_t; g = A_g_ffn + DM; mode = 2; } \
            else { r -= I_GU; W = A_w_down + (size_t)DFF * DM; K = DFF; N = DM; WT = A_Wd1_t; g = nullptr; mode = 0; } \
            const int nblk = N / 64, kb = r / nblk, nb = r - kb * nblk, n0 = nb * 64, k0 = kb * 64; \
            const int drow0 = mode == 0 ? roff + n0 : (n0 >> 7) * 256 + (n0 & 127) + (mode == 2 ? 128 : 0); \
            T.src = W + (size_t)(k0 + 2 * (F.lane >> 4)) * N + n0 + 4 * (F.lane & 15); T.dst = WT + (size_t)drow0 * K + k0; T.gain = g ? g + k0 : nullptr; T.N = N; T.K = K; } while (0)
#define P0_RUN(first, count, gw_, NGW_) do { LAS unsigned* scr = (LAS unsigned*)(F.lds + RING_OFF + F.wave * 16384); TItem ta{}, tb{}; f32x4 va[16] = {}, vb[16] = {}; const int cnt_ = (count), ngw_ = (NGW_); \
        int it = (gw_); \
        if (it < cnt_) { P0_DECODE((first) + it, ta); P0_LOAD(ta, va); } \
        while (it < cnt_) { \
            const int it2 = it + ngw_, it3 = it2 + ngw_; \
            if (it2 < cnt_) { P0_DECODE((first) + it2, tb); P0_LOAD(tb, vb); } \
            p0_process(ta, va, scr, F.lane); \
            if (it2 >= cnt_) break; \
            if (it3 < cnt_) { P0_DECODE((first) + it3, ta); P0_LOAD(ta, va); } \
            p0_process(tb, vb, scr, F.lane); \
            it = it3; \
        } } while (0)
__global__ void __launch_bounds__(NWAVES * 64, 2) fwd_kernel(Args args) {
    extern __shared__ __attribute__((aligned(16))) unsigned char lds[];
    Frame F;
    F.lds = (LAS unsigned char*)lds;
    F.MISC = (volatile LAS unsigned*)(F.lds + MISC_OFF);
    const int wave_s = __builtin_amdgcn_readfirstlane((int)threadIdx.x >> 6);
    F.tid = threadIdx.x; F.lane = F.tid & 63; F.wave = wave_s;
    F.G = gridDim.x; { const int bx = blockIdx.x; F.vcu = (F.G % 8 == 0) ? (bx % 8) * (F.G / 8) + bx / 8 : bx; }
    { ARGP(); F.ctl = (gu32*)(ap->ws + WS_CTL); }
#define A_x        (ap->in[0])
#define A_rel_bias (ap->in[1])
#define A_g_attn   (ap->in[2])
#define A_g_ffn    (ap->in[3])
#define A_w_qkv    (ap->in[4])
#define A_w_o_a    (ap->in[5])
#define A_g_q_a    (ap->in[6])
#define A_g_k_a    (ap->in[7])
#define A_lam_qk   (ap->in[8])
#define A_g_sub    (ap->in[9])
#define A_g_kvn    (ap->in[10])
#define A_w_kv     (ap->in[11])
#define A_g_k_sh   (ap->in[12])
#define A_w_q_b    (ap->in[13])
#define A_w_o_b    (ap->in[14])
#define A_g_q_b    (ap->in[15])
#define A_sinks    (ap->in[16])
#define A_w_gate   (ap->in[17])
#define A_w_up     (ap->in[18])
#define A_w_down   (ap->in[19])
#define A_out      (ap->out)
#define WSB(off) ((bf16*)(ap->ws + (off)))
#define A_Wqkv_t WSB(WS_WQKV)
#define A_Woa_t  WSB(WS_WOA)
#define A_Wgu0_t WSB(WS_WGU0)
#define A_Wd0_t  WSB(WS_WD0)
#define A_Wkvq_t WSB(WS_WKVQ)
#define A_Wob_t  WSB(WS_WOB)
#define A_Wgu1_t WSB(WS_WGU1)
#define A_Wd1_t  WSB(WS_WD1)
#define A_H  WSB(WS_H)
#define A_R1 WSB(WS_R1)
#define A_R2 WSB(WS_R2)
#define A_XB WSB(WS_XB)
#define A_SS(k) ((float*)(ap->ws + WS_SS + (size_t)(k) * M * 4))
    for (int u = F.tid; u < (LDS_BYTES - LDSCTL_OFF) / 4; u += NWAVES * 64) ((LAS unsigned*)(F.lds + LDSCTL_OFF))[u] = 0u;
    __syncthreads();
    (void)xcd_barrier_post((unsigned*)(F.ctl + CW_BAR), F.MISC + 8);
    if (F.tid == 0 && (xb_xcc_id() != ((unsigned)blockIdx.x & 7u) || (gridDim.x & 7u) != 0u)) __hip_atomic_fetch_or(F.ctl + CW_MAPBAD, 1u, RLX_AGENT);
#define GRID_BAR() grid_bar()
#ifndef PH_MASK
#define PH_MASK 0x1ffff
#endif
#ifndef PROBE_TWICE
#define PROBE_TWICE 0
#endif
#ifndef PROBE_LAYER
#define PROBE_LAYER 0
#endif
#define PH(k) _Pragma("nounroll") for (int rep_ = 0; rep_ < (((((PROBE_TWICE) >> (k)) & 1) && layer == (PROBE_LAYER)) ? 2 : 1); ++rep_, ((((PROBE_TWICE) >> (k)) & 1) && rep_ == 1 ? (GRID_BAR(), 0) : 0)) if constexpr (((PH_MASK) >> (k)) & 1)

    int layer = 0;
    PH(0)
    {
        ARGP(); TIDP();
        P0_RUN(0, (NCONV) ? I_QKV : NITEMS, F.vcu * NWAVES + F.wave, F.G * NWAVES);
        raw_rows(F, A_x, A_XB, A_SS(0));
    }
    GRID_BAR();
    if (F.tid == 0) F.MISC[17] = (__hip_atomic_load(F.ctl + CW_MAPBAD, RLX_AGENT) == 0u) ? 1u : 0u;
    __syncthreads();
    for (layer = 0; layer < 2; ++layer) {
        const bool L0 = layer == 0;
        const int NP = L0 ? NQKV : NKVQ;
        PH(1)
        {
            ARGP();
            pg8::Gemm g{A_XB, L0 ? A_Wqkv_t : A_Wkvq_t, M, NP, DM, DM}; pg8::StaticOrder S; S.init(M, NP, F.G, (int)blockIdx.x);
            pg8::EpiProj E{A_R1, NQKV, L0 ? A_SS(0) : A_SS(2), 1.0f / DM, EPS, L0 ? A_g_q_a : A_g_k_sh, L0 ? A_g_k_a : A_g_q_b, 0, L0 ? 16 : 4, L0 ? 16 : 8, L0 ? 32 : 24, L0 ? QSCALE : 1.0f, L0 ? 1.0f : QSCALE, EPS,
                           (PG8_LAS float*)(F.lds + att::LDS_LUT)};
            pg8::gemm_phase<pg8::EpiProj, pg8::StaticOrder, true, true>(F.lds + RING_OFF, g, S, E, phase_tid(wave_s));
        }
        GRID_BAR();
        PH(3)
        {
            ARGP(); TIDP();
            if (L0) {
                const int GS = (F.G % 8 == 0) ? F.G / 8 : F.G, xg = F.vcu / GS, lc = F.vcu - xg * GS, NGRP = F.G / GS, HPG = 32 / NGRP, QN = HPG * 64;
                constexpr int NCV = NCONV;
                if (lc >= GS - NCV) { P0_RUN(I_QKV, NITEMS - I_QKV, (xg * NCV + lc - (GS - NCV)) * NWAVES + F.wave, NGRP * NCV * NWAVES); }
                __syncthreads();
                fill_lut(F, A_rel_bias, A_g_q_a, A_g_k_a);
                const float* lq = A_lam_qk;
                float s1 = lq[F.lane] * lq[128 + F.lane] + lq[64 + F.lane] * lq[192 + F.lane], s2 = lq[256 + F.lane] * lq[384 + F.lane] + lq[320 + F.lane] * lq[448 + F.lane];
                s1 = wave_sum(s1, F.lane); s2 = wave_sum(s2, F.lane);
                const float lam = expf(s1) - expf(s2) + LAMBDA_INIT;
                const att::Stg stg = att::make_stg<NQKV>(F.wave, F.lane);
                const att::rsrc_t rs = __builtin_amdgcn_make_buffer_rsrc((void*)A_R1, 0, (int)((size_t)M * NQKV * 2), 0x00020000);
                gu32* qctr = F.ctl + CW_QUEUE + 64 * xg;
                const bf16* Hb = A_H;
                auto ref = [=](int jj, att::Block2& r) { const int rk = jj / HPG, bh = xg * HPG + jj - rk * HPG, qb = 63 - rk, b = bh >> 4, hh = bh & 15;
                    const unsigned base = (unsigned)b * (SEQ * NQKV * 2u) + hh * 512u;
                    r.Q = base + (unsigned)qb * (128u * NQKV * 2u); r.K = base + 4096u * 2u; r.V = base + 8192u * 2u;
                    r.O = (bf16*)Hb + ((size_t)b * SEQ + (size_t)qb * 128) * DM + hh * 256; r.P0 = qb * 128; r.map0 = 2 * hh; r.rev = 0; };
                int j;
                if (F.tid == 0) F.MISC[16] = __hip_atomic_fetch_add(qctr, 1u, RLX_AGENT);
                __syncthreads(); j = __builtin_amdgcn_readfirstlane((int)F.MISC[16]); __syncthreads();
                if (j < QN) {
                    att::Block2 cur; ref(j, cur); att::Seam2 S;
                    att::attn2_prime<NQKV>(rs, cur, (char*)lds + RING_OFF, S, stg, F.tid);
                    for (;;) {
                        j = att::attn2_block<NQKV, DM>(rs, cur, (unsigned*)qctr, F.MISC + 16, QN, ref, (char*)lds + RING_OFF, S, stg, F.tid, lam, A_g_sub, 1.0f - LAMBDA_INIT, EPS);
                        if (j >= QN) break;
                        ref(j, cur);
                    }
                }
            } else {
                fill_lut(F, A_rel_bias, A_g_q_b, A_g_k_sh);
                constexpr int NITEM = 2048;
                const att::rsrc_t rs = __builtin_amdgcn_make_buffer_rsrc((void*)A_R1, 0, (int)((size_t)M * NQKV * 2), 0x00020000);
                const att::Stg stg = att::make_stg<NQKV>(F.wave, F.lane);
#define ATT_REF(r, L) do { const int bh = (L) >> 5, qb = (L) & 31, b = bh >> 5, h = bh & 31; const unsigned base = (unsigned)b * (SEQ * NQKV * 2u); \
                r.Q = base + (unsigned)qb * (256u * NQKV * 2u) + (2048u + h * 128u) * 2u; r.K = base + (unsigned)(h >> 2) * 256u; r.V = base + (1024u + (h >> 2) * 128u) * 2u; \
                r.O = A_R2 + ((size_t)b * SEQ + (size_t)qb * 256) * 8192 + h * 128; r.P0 = qb * 256; r.map = h; r.sink2 = A_sinks[h] * LOG2E; } while (0)
                int L = blockIdx.x; asm volatile("" : "+s"(L));
                if (L < NITEM) {
                    att::BlockRef cur; ATT_REF(cur, L); att::Seam S;
                    att::attn_prime<NQKV>(rs, cur, 128, (char*)lds + RING_OFF, S, stg, F.tid);
                    for (;;) {
                        const bool last = L + (int)gridDim.x >= NITEM; const int Ln = last ? L : L + (int)gridDim.x;
                        att::BlockRef nxt = cur; if (!last) ATT_REF(nxt, Ln);
                        att::attn_block<NQKV, 8192>(rs, cur, nxt, SEQ, 128, (char*)lds + RING_OFF, S, stg, F.tid);
                        if (last) break;
                        cur = nxt; L = Ln;
                    }
                }
#undef ATT_REF
            }
        }
        GRID_BAR();
        PH(5)
        {
            ARGP();
            pg8::Gemm g{L0 ? A_H : A_R2, L0 ? A_Woa_t : A_Wob_t, M, DM, DM, L0 ? DM : 8192};     pg8::StaticOrder S; S.init(M, DM, F.G, (int)blockIdx.x);
            pg8::EpiResF32 E{L0 ? A_x : (const float*)nullptr, A_XB, (float*)nullptr, DM, A_XB, L0 ? A_SS(1) : A_SS(3)};
            pg8::gemm_phase<pg8::EpiResF32, pg8::StaticOrder, true, true>(F.lds + RING_OFF, g, S, E, phase_tid(wave_s));
        }
        seam_bar();
        PH(7)
        {
            ARGP();
            pg8::Gemm g{A_XB, L0 ? A_Wgu0_t : A_Wgu1_t, M, NGU, DM, DM}; pg8::StaticOrder S; S.init(M, NGU, F.G, (int)blockIdx.x);
            pg8::EpiSwiGLU E{A_R1, DFF, L0 ? A_SS(1) : A_SS(3), 1.0f / DM, EPS};
            pg8::gemm_phase<pg8::EpiSwiGLU, pg8::StaticOrder, true, true>(F.lds + RING_OFF, g, S, E, phase_tid(wave_s));
        }
        seam_bar();
        PH(8)
        {
            ARGP();
            pg8::Gemm g{A_R1, L0 ? A_Wd0_t : A_Wd1_t, M, DM, DFF, DFF}; pg8::StaticOrder S; S.init(M, DM, F.G, (int)blockIdx.x, 4);
            pg8::EpiResF32 E{(const float*)nullptr, A_XB, L0 ? (float*)nullptr : A_out, DM, L0 ? A_XB : (bf16*)nullptr, A_SS(2)};
            pg8::gemm_phase<pg8::EpiResF32, pg8::StaticOrder, true, true>(F.lds + RING_OFF, g, S, E, phase_tid(wave_s));
        }
        if (L0) GRID_BAR();
    }
}

extern "C" void kernel_launch(void* const* d_in, const int* in_sizes, int n_in, void* d_out, int out_size, void* d_ws, size_t ws_size, hipStream_t stream) {
    static int grid = 0;
    if (grid == 0) {
        if (n_in != 20 || in_sizes[0] != M * DM || out_size != M * DM || ws_size < WS_END) { fprintf(stderr, "kernel_launch: shape/workspace mismatch: n_in %d in0 %d out %d ws %zu (need %zu)\n", n_in, n_in > 0 ? in_sizes[0] : -1, out_size, ws_size, (size_t)WS_END); grid = -1; return; }
        int dev = 0, cus = 0, per_cu = 0;
        if (hipGetDevice(&dev) != hipSuccess || hipDeviceGetAttribute(&cus, hipDeviceAttributeMultiprocessorCount, dev) != hipSuccess) { grid = -1; return; }
        if (hipFuncSetAttribute((const void*)fwd_kernel, hipFuncAttributeMaxDynamicSharedMemorySize, LDS_BYTES) != hipSuccess) { fprintf(stderr, "kernel_launch: hipFuncSetAttribute failed\n"); grid = -1; return; }
        if (hipOccupancyMaxActiveBlocksPerMultiprocessor(&per_cu, (const void*)fwd_kernel, NWAVES * 64, LDS_BYTES) != hipSuccess || per_cu < 1) { fprintf(stderr, "kernel_launch: occupancy query says %d blocks per CU\n", per_cu); grid = -1; (void)hipGetLastError(); return; }
        grid = cus;
    }
    if (grid < 0) return;
    if (hipMemsetAsync((char*)d_ws + WS_CTL, 0, CTL_ZERO_BYTES, stream) != hipSuccess) return;
    Args a{};
    for (int i = 0; i < 20; ++i) a.in[i] = (const float*)d_in[i];
    a.out = (float*)d_out; a.ws = (unsigned char*)d_ws;
    hipLaunchKernelGGL(fwd_kernel, dim3(grid), dim3(NWAVES * 64), LDS_BYTES, stream, a);
}
```

```cpp
#include <hip/hip_runtime.h>
#include <hip/hip_bf16.h>
#include <cstdio>
#include <cstdint>
#include <cmath>

__device__ __forceinline__ int phase_tid(int wave_s) { int lane; asm volatile("v_mbcnt_lo_u32_b32 %0, -1, 0\n\tv_mbcnt_hi_u32_b32 %0, -1, %0" : "=v"(lane)); return wave_s * 64 + lane; }

__device__ __forceinline__ float shflx(float v, int k, int lane) { return __builtin_bit_cast(float, __builtin_amdgcn_ds_bpermute((lane ^ k) << 2, __builtin_bit_cast(int, v))); }
template <int CTRL> __device__ __forceinline__ float dppx(float a) { return __builtin_bit_cast(float, __builtin_amdgcn_update_dpp(0, __builtin_bit_cast(int, a), CTRL, 0xf, 0xf, true)); }
__device__ __forceinline__ float swz16(float a) { return __builtin_bit_cast(float, __builtin_amdgcn_ds_swizzle(__builtin_bit_cast(int, a), 0x401F)); }
__device__ __forceinline__ float sum16(float a) { a += dppx<0xB1>(a); a += dppx<0x4E>(a); a += dppx<0x141>(a); a += dppx<0x140>(a); return a; }
namespace pg8 {
#define PG8_LAS __attribute__((address_space(3)))
typedef unsigned short bf16_t;
typedef short bf16x8 __attribute__((ext_vector_type(8)));
typedef float f32x4 __attribute__((ext_vector_type(4)));
typedef unsigned u32x4 __attribute__((ext_vector_type(4)));
constexpr int BM = 256, BK = 64, HALF = 128, HTB = HALF * BK * 2  , STAGE_BYTES = 8 * HTB, NXCD = 8, WGM = 8;

__host__ __device__ __forceinline__ int lds_byte(int r, int c) { const int st = (r >> 4) * 2 + (c >> 5), rr = r & 15, cc = c & 31, ob = rr * 64 + cc * 2; return st * 1024 + (ob ^ (((ob >> 9) & 1) << 5)); }
__host__ __device__ __forceinline__ void stage_rc(int b, int& R, int& C) { const int st = b / 1024, sb = b % 1024, swz = sb ^ (((sb >> 9) & 1) << 5); R = (st >> 1) * 16 + swz / 64; C = (st & 1) * 32 + (swz % 64) / 2; }
__host__ __device__ __forceinline__ int perm32(int rho) { const int n = rho >> 4, i = rho & 15; return 8 * (i >> 2) + 4 * n + (i & 3); }

struct Unit { int pm, pn; };
struct Gemm { const bf16_t* A; const bf16_t* Bt; int M, N, K, lda; };

struct StaticOrder {
    int nM, nN, nwg, G, c, wgm;
    __host__ __device__ void init(int M, int N, int G_, int c_, int wgm_ = WGM) { nM = M / BM; nN = N / BM; nwg = nM * nN; G = G_; c = c_; wgm = wgm_; }
    __host__ __device__ bool next(int i, Unit& u) const {
        const long L = (long)i * G + c; if (L >= nwg) return false;
        int wgid = (int)L; { const int q = nwg / NXCD, r = nwg % NXCD, xcd = wgid % NXCD, off = wgid / NXCD; wgid = (xcd < r ? xcd * (q + 1) : r * (q + 1) + (xcd - r) * q) + off; }
        const int nig = wgm * nN, gid = wgid / nig, fm = gid * wgm, gsz = (nM - fm) < wgm ? (nM - fm) : wgm;
        u.pm = fm + ((wgid % nig) % gsz); u.pn = (wgid % nig) / gsz; return true;
    }
    __device__ __forceinline__ void a_ready(const Unit&) const {}
    __device__ __forceinline__ void done(const Unit&) const {}
};

__device__ __forceinline__ unsigned cvt_pk_bf16(float lo, float hi) { unsigned r; asm volatile("v_cvt_pk_bf16_f32 %0, %1, %2" : "=v"(r) : "v"(lo), "v"(hi)); return r; }
typedef float f32x2 __attribute__((ext_vector_type(2)));
struct EpiStoreBf16 {
    static constexpr bool PERM = true, AFTER_DRAIN = false;
    bf16_t* O; int ldc; const float* ss; float inv_k, eps;
    struct State { float rs[2][4]; };
    __device__ __forceinline__ void prep(State& s, const Unit& u, int wr, int fr) const {
        const int row0 = u.pm * BM + wr * 64 + fr; float t[2][4];
#pragma unroll
        for (int ai = 0; ai < 2; ++ai)
#pragma unroll
            for (int m = 0; m < 4; ++m) t[ai][m] = __builtin_nontemporal_load(ss + row0 + ai * HALF + m * 16);
#pragma unroll
        for (int ai = 0; ai < 2; ++ai)
#pragma unroll
            for (int m = 0; m < 4; ++m) s.rs[ai][m] = __builtin_amdgcn_rsqf(t[ai][m] * inv_k + eps);
    }
    __device__ __forceinline__ void operator()(const f32x4 (&acc)[2][2][4][2], const Unit& u, int wr, int wc, int fr, int fq, const State& st) const {
        const int row0 = u.pm * BM + wr * 64 + fr, col0 = u.pn * BM + wc * 32 + 8 * fq;
#pragma unroll
        for (int ai = 0; ai < 2; ++ai)
#pragma unroll
            for (int m = 0; m < 4; ++m) { bf16_t* rowp = O + (size_t)(row0 + ai * HALF + m * 16) * ldc + col0; const float r = st.rs[ai][m];
#pragma unroll
                for (int bj = 0; bj < 2; ++bj) { const f32x4 v0 = acc[ai][bj][m][0] * r, v1 = acc[ai][bj][m][1] * r;
                    u32x4 w; w.x = cvt_pk_bf16(v0[0], v0[1]); w.y = cvt_pk_bf16(v0[2], v0[3]); w.z = cvt_pk_bf16(v1[0], v1[1]); w.w = cvt_pk_bf16(v1[2], v1[3]);
                    *(u32x4*)(rowp + bj * HALF) = w; } }
    }
};
struct EpiProj {
    static constexpr bool PERM = true, AFTER_DRAIN = false;
    bf16_t* O; int ldc; const float* ss; float inv_k, eps;
    const float* gA; const float* gB; int a0, a1, b0, b1; float sA, sB, heps;
    PG8_LAS float* xs;
    struct State { float rs[2][4]; };
    __device__ __forceinline__ void prep(State& s, const Unit& u, int wr, int fr) const {
        const int row0 = u.pm * BM + wr * 64 + fr; float t[2][4];
#pragma unroll
        for (int ai = 0; ai < 2; ++ai)
#pragma unroll
            for (int m = 0; m < 4; ++m) t[ai][m] = __builtin_nontemporal_load(ss + row0 + ai * HALF + m * 16);
#pragma unroll
        for (int ai = 0; ai < 2; ++ai)
#pragma unroll
            for (int m = 0; m < 4; ++m) s.rs[ai][m] = __builtin_amdgcn_rsqf(t[ai][m] * inv_k + eps);
    }
    __device__ __forceinline__ void operator()(const f32x4 (&acc)[2][2][4][2], const Unit& u, int wr, int wc, int fr, int fq, const State& st) const {
        const int row0 = u.pm * BM + wr * 64 + fr, col0 = u.pn * BM + wc * 32 + 8 * fq;
        const int mode = (u.pn >= a0 && u.pn < a1) ? 1 : ((u.pn >= b0 && u.pn < b1) ? 2 : 0);
        float hr[2][2][4];
        f32x4 gv[2] = {(f32x4){1.f, 1.f, 1.f, 1.f}, (f32x4){1.f, 1.f, 1.f, 1.f}};
        if (mode) {
            const int lane = fq * 16 + fr;
            float sv[2][4][2];
#pragma unroll
            for (int ai = 0; ai < 2; ++ai)
#pragma unroll
                for (int m = 0; m < 4; ++m)
#pragma unroll
                    for (int bj = 0; bj < 2; ++bj) { const f32x4 v0 = acc[ai][bj][m][0] * st.rs[ai][m], v1 = acc[ai][bj][m][1] * st.rs[ai][m];
                        sv[ai][m][bj] = (v0[0] * v0[0] + v0[1] * v0[1]) + (v0[2] * v0[2] + v0[3] * v0[3]) + (v1[0] * v1[0] + v1[1] * v1[1]) + (v1[2] * v1[2] + v1[3] * v1[3]); }
#pragma unroll
            for (int ai = 0; ai < 2; ++ai)
#pragma unroll
                for (int m = 0; m < 4; ++m)
#pragma unroll
                    for (int bj = 0; bj < 2; ++bj) sv[ai][m][bj] += swz16(sv[ai][m][bj]);
            float tv[2][4][2];
#pragma unroll
            for (int ai = 0; ai < 2; ++ai)
#pragma unroll
                for (int m = 0; m < 4; ++m)
#pragma unroll
                    for (int bj = 0; bj < 2; ++bj) tv[ai][m][bj] = shflx(sv[ai][m][bj], 32, lane);
            if (fq == 0) {
#pragma unroll
                for (int ai = 0; ai < 2; ++ai)
#pragma unroll
                    for (int m = 0; m < 4; ++m)
#pragma unroll
                        for (int bj = 0; bj < 2; ++bj) xs[((wr * 2 + bj) * 128 + ai * 64 + m * 16 + fr) * 4 + wc] = sv[ai][m][bj] + tv[ai][m][bj];
            }
            const float* g = mode == 1 ? gA : gB; const float sc = mode == 1 ? sA : sB;
            gv[0] = *(const f32x4*)(g + wc * 32 + 8 * fq) * sc; gv[1] = *(const f32x4*)(g + wc * 32 + 8 * fq + 4) * sc;
            asm volatile("s_waitcnt lgkmcnt(0)" ::: "memory"); __builtin_amdgcn_s_barrier(); asm volatile("" ::: "memory");
#pragma unroll
            for (int ai = 0; ai < 2; ++ai)
#pragma unroll
                for (int m = 0; m < 4; ++m)
#pragma unroll
                    for (int bj = 0; bj < 2; ++bj) { const f32x4 t = *(const PG8_LAS f32x4*)(xs + ((wr * 2 + bj) * 128 + ai * 64 + m * 16 + fr) * 4);
                        hr[ai][bj][m] = __builtin_amdgcn_rsqf(((t[0] + t[1]) + (t[2] + t[3])) * (1.0f / 128.0f) + heps) * st.rs[ai][m]; }
        } else {
#pragma unroll
            for (int ai = 0; ai < 2; ++ai)
#pragma unroll
                for (int m = 0; m < 4; ++m) { hr[ai][0][m] = st.rs[ai][m]; hr[ai][1][m] = st.rs[ai][m]; }
        }
#pragma unroll
        for (int ai = 0; ai < 2; ++ai)
#pragma unroll
            for (int m = 0; m < 4; ++m) { bf16_t* rowp = O + (size_t)(row0 + ai * HALF + m * 16) * ldc + col0;
#pragma unroll
                for (int bj = 0; bj < 2; ++bj) { const f32x4 v0 = acc[ai][bj][m][0] * hr[ai][bj][m] * gv[0], v1 = acc[ai][bj][m][1] * hr[ai][bj][m] * gv[1];
                    u32x4 w; w.x = cvt_pk_bf16(v0[0], v0[1]); w.y = cvt_pk_bf16(v0[2], v0[3]); w.z = cvt_pk_bf16(v1[0], v1[1]); w.w = cvt_pk_bf16(v1[2], v1[3]);
                    *(u32x4*)(rowp + bj * HALF) = w; } }
    }
};
struct EpiSwiGLU {
    static constexpr bool PERM = true, AFTER_DRAIN = false;
    bf16_t* O; int ldc; const float* ss; float inv_k, eps;
    struct State { float rs[2][4]; };
    __device__ __forceinline__ void prep(State& s, const Unit& u, int wr, int fr) const {
        const int row0 = u.pm * BM + wr * 64 + fr; float t[2][4];
#pragma unroll
        for (int ai = 0; ai < 2; ++ai)
#pragma unroll
            for (int m = 0; m < 4; ++m) t[ai][m] = __builtin_nontemporal_load(ss + row0 + ai * HALF + m * 16);
#pragma unroll
        for (int ai = 0; ai < 2; ++ai)
#pragma unroll
            for (int m = 0; m < 4; ++m) s.rs[ai][m] = __builtin_amdgcn_rsqf(t[ai][m] * inv_k + eps);
    }
    __device__ __forceinline__ void operator()(const f32x4 (&acc)[2][2][4][2], const Unit& u, int wr, int wc, int fr, int fq, const State& st) const {
        const int row0 = u.pm * BM + wr * 64 + fr, col0 = u.pn * HALF + wc * 32 + 8 * fq;
#pragma unroll
        for (int ai = 0; ai < 2; ++ai)
#pragma unroll
            for (int m = 0; m < 4; ++m) { bf16_t* rowp = O + (size_t)(row0 + ai * HALF + m * 16) * ldc + col0; const float rstd = st.rs[ai][m];
                float r[8];
#pragma unroll
                for (int n = 0; n < 2; ++n)
#pragma unroll
                    for (int e = 0; e < 4; ++e) { const float g = acc[ai][0][m][n][e] * rstd, up = acc[ai][1][m][n][e] * rstd;
                        const float s = __builtin_amdgcn_rcpf(1.0f + __builtin_amdgcn_exp2f(-1.4426950408889634f * g));
                        r[n * 4 + e] = g * s * up; }
                u32x4 w; w.x = cvt_pk_bf16(r[0], r[1]); w.y = cvt_pk_bf16(r[2], r[3]); w.z = cvt_pk_bf16(r[4], r[5]); w.w = cvt_pk_bf16(r[6], r[7]);
                *(u32x4*)rowp = w; }
    }
};
struct EpiResF32 {
    static constexpr bool PERM = true, AFTER_DRAIN = false;
    const float* res32; const bf16_t* res16; float* out32; int ldc; bf16_t* xb; float* ss;
    struct State {};
    __device__ __forceinline__ void prep(State&, const Unit&, int, int) const {}
    __device__ __forceinline__ void operator()(const f32x4 (&acc)[2][2][4][2], const Unit& u, int wr, int wc, int fr, int fq, const State&) const {
        const int row0 = u.pm * BM + wr * 64 + fr, col0 = u.pn * BM + wc * 32 + 8 * fq;
        float sacc[2][4];
#pragma unroll
        for (int ai = 0; ai < 2; ++ai)
#pragma unroll
            for (int m = 0; m < 4; ++m) { const int row = row0 + ai * HALF + m * 16; const size_t off = (size_t)row * ldc + col0;
                f32x4 rv[2][2];
                if (res32) {
#pragma unroll
                    for (int bj = 0; bj < 2; ++bj)
#pragma unroll
                        for (int n = 0; n < 2; ++n) rv[bj][n] = *(const f32x4*)(res32 + off + bj * HALF + n * 4);
                } else {
#pragma unroll
                    for (int bj = 0; bj < 2; ++bj) { const u32x4 w = *(const u32x4*)(res16 + off + bj * HALF);
                        rv[bj][0] = (f32x4){__uint_as_float(w.x << 16), __uint_as_float(w.x & 0xffff0000u), __uint_as_float(w.y << 16), __uint_as_float(w.y & 0xffff0000u)};
                        rv[bj][1] = (f32x4){__uint_as_float(w.z << 16), __uint_as_float(w.z & 0xffff0000u), __uint_as_float(w.w << 16), __uint_as_float(w.w & 0xffff0000u)}; }
                }
                float s = 0.f;
#pragma unroll
                for (int bj = 0; bj < 2; ++bj) { const f32x4 v0 = rv[bj][0] + acc[ai][bj][m][0], v1 = rv[bj][1] + acc[ai][bj][m][1];
                    if (out32) { *(f32x4*)(out32 + off + bj * HALF) = v0; *(f32x4*)(out32 + off + bj * HALF + 4) = v1; }
                    if (xb) { u32x4 w; w.x = cvt_pk_bf16(v0[0], v0[1]); w.y = cvt_pk_bf16(v0[2], v0[3]); w.z = cvt_pk_bf16(v1[0], v1[1]); w.w = cvt_pk_bf16(v1[2], v1[3]); *(u32x4*)(xb + off + bj * HALF) = w;
                        s += ((v0[0] * v0[0] + v0[1] * v0[1]) + (v0[2] * v0[2] + v0[3] * v0[3])) + ((v1[0] * v1[0] + v1[1] * v1[1]) + (v1[2] * v1[2] + v1[3] * v1[3])); } }
                sacc[ai][m] = s; }
        if (xb) {
#pragma unroll
            for (int ai = 0; ai < 2; ++ai)
#pragma unroll
                for (int m = 0; m < 4; ++m) sacc[ai][m] += swz16(sacc[ai][m]);
            float tacc[2][4];
#pragma unroll
            for (int ai = 0; ai < 2; ++ai)
#pragma unroll
                for (int m = 0; m < 4; ++m) tacc[ai][m] = shflx(sacc[ai][m], 32, fq * 16 + fr);
#pragma unroll
            for (int ai = 0; ai < 2; ++ai)
#pragma unroll
                for (int m = 0; m < 4; ++m) { if (fq == 0) unsafeAtomicAdd(ss + row0 + ai * HALF + m * 16, sacc[ai][m] + tacc[ai][m]); }
        }
    }
};
template <class Epi, class Sched, bool ALIGN_EPI = false, bool SP2 = false>
__device__ __forceinline__ void gemm_phase(PG8_LAS unsigned char* lds, const Gemm g, const Sched& S, const Epi& E, int tid) {
    asm volatile("" : "+v"(tid));
    const int wid = __builtin_amdgcn_readfirstlane(tid >> 6), lane = tid & 63, wr = wid >> 2, wc = wid & 3, fr = lane & 15, fq = lane >> 4;
    const int K = g.K, nt = K / BK;
    unsigned voffA[2], voffB[2];
#pragma unroll
    for (int i = 0; i < 2; ++i) { int R, C; stage_rc(tid * 16 + i * 8192, R, C); const int Rb = Epi::PERM ? ((R & ~31) + perm32(R & 31)) : R;
        voffA[i] = (unsigned)(R * g.lda + C) * 2u; voffB[i] = (unsigned)(Rb * K + C) * 2u; }
    const size_t kstep = (size_t)(BK * 2);
    const size_t hstep = (size_t)HALF * K * 2;
    const size_t hstepA = (size_t)HALF * g.lda * 2, tstepA = 2 * hstepA;
    const size_t tstep = 2 * hstep;
    const unsigned ldsw = (unsigned)wid * 1024u;
    const int aoff = lds_byte(wr * 64 + fr, fq * 8), boff = lds_byte(wc * 32 + fr, fq * 8);
#define PG8_SA(b, h) (((b) * 2 + (h)) * HTB)
#define PG8_SB(b, h) ((4 + (b) * 2 + (h)) * HTB)
#define PG8_STAGE(bufoff, gbase, voff) do { _Pragma("unroll") for (int _i = 0; _i < 2; ++_i) \
        __builtin_amdgcn_global_load_lds((const unsigned*)((const char*)(gbase) + (voff)[_i]), (PG8_LAS unsigned*)(lds + (bufoff) + ldsw + _i * 8192), 16, 0, 0); } while (0)
#define PG8_LDA(dst, b, h) do { _Pragma("unroll") for (int m = 0; m < 4; ++m) _Pragma("unroll") for (int k = 0; k < 2; ++k) dst[m][k] = *(const PG8_LAS bf16x8*)(lds + PG8_SA(b, h) + aoff + m * 2048 + k * 1024); } while (0)
#define PG8_LDB(dst, b, h) do { _Pragma("unroll") for (int n = 0; n < 2; ++n) _Pragma("unroll") for (int k = 0; k < 2; ++k) dst[n][k] = *(const PG8_LAS bf16x8*)(lds + PG8_SB(b, h) + boff + n * 2048 + k * 1024); } while (0)
#define PG8_MMA(ai, bj, At, Bt) do { __builtin_amdgcn_s_setprio(1); _Pragma("unroll") for (int m = 0; m < 4; ++m) _Pragma("unroll") for (int n = 0; n < 2; ++n) _Pragma("unroll") for (int k = 0; k < 2; ++k) \
        acc[ai][bj][m][n] = __builtin_amdgcn_mfma_f32_16x16x32_bf16(Bt[n][k], At[m][k], acc[ai][bj][m][n], 0, 0, 0); __builtin_amdgcn_s_setprio(0); } while (0)
#define PG8_WAIT_V(n) asm volatile("s_waitcnt vmcnt(" #n ")" ::: "memory")
#define PG8_WAIT_L(n) asm volatile("s_waitcnt lgkmcnt(" #n ")" ::: "memory")
#define PG8_BAR __builtin_amdgcn_s_barrier()
#define PG8_SCHED __builtin_amdgcn_sched_barrier(0)
    Unit cur, nxt; int ui = 0;
    if (!S.next(0, cur)) return;
    typename Epi::State est; int est_pm = -1;
    f32x4 acc[2][2][4][2];
#pragma unroll
    for (int a = 0; a < 2; ++a)
#pragma unroll
        for (int b = 0; b < 2; ++b)
#pragma unroll
            for (int m = 0; m < 4; ++m)
#pragma unroll
                for (int n = 0; n < 2; ++n) acc[a][b][m][n] = (f32x4){0.f, 0.f, 0.f, 0.f};
    bf16x8 At[4][2], B0[2][2], B1[2][2];
    const char* cA = (const char*)g.A + (size_t)cur.pm * tstepA; const char* cB = (const char*)g.Bt + (size_t)cur.pn * tstep;
    S.a_ready(cur);
    if constexpr (SP2) {
        PG8_STAGE(PG8_SB(0, 0), cB, voffB); PG8_STAGE(PG8_SB(0, 1), cB + hstep, voffB); PG8_STAGE(PG8_SA(0, 0), cA, voffA); PG8_STAGE(PG8_SA(0, 1), cA + hstepA, voffA);
        if (wr == 1) PG8_BAR;
        PG8_WAIT_V(2); PG8_BAR;
        PG8_STAGE(PG8_SB(1, 0), cB + kstep, voffB); PG8_STAGE(PG8_SA(1, 0), cA + kstep, voffA); PG8_STAGE(PG8_SB(1, 1), cB + hstep + kstep, voffB);
        PG8_WAIT_V(6); PG8_BAR;
    } else {
        PG8_STAGE(PG8_SB(0, 0), cB, voffB); PG8_STAGE(PG8_SA(0, 0), cA, voffA); PG8_STAGE(PG8_SB(0, 1), cB + hstep, voffB); PG8_STAGE(PG8_SA(0, 1), cA + hstepA, voffA);
        if (wr == 1) PG8_BAR;
        PG8_WAIT_V(4); PG8_BAR;
        PG8_STAGE(PG8_SB(1, 0), cB + kstep, voffB); PG8_STAGE(PG8_SA(1, 0), cA + kstep, voffA); PG8_STAGE(PG8_SB(1, 1), cB + hstep + kstep, voffB);
        PG8_WAIT_V(6); PG8_BAR;
    }
    for (;;) {
        const bool has_next = S.next(ui + 1, nxt);
        const char* nA = has_next ? (const char*)g.A + (size_t)nxt.pm * tstepA : cA; const char* nB = has_next ? (const char*)g.Bt + (size_t)nxt.pn * tstep : cB;
        for (int t = 0; t < nt; t += 2) {
            const bool last = (t == nt - 2);
            const char* a1 = cA + (size_t)(t + 1) * kstep;
            const char* a2 = last ? nA : cA + (size_t)(t + 2) * kstep; const char* b2 = last ? nB : cB + (size_t)(t + 2) * kstep;
            const char* a3 = a2 + kstep; const char* b3 = b2 + kstep;
            if (last && has_next) S.a_ready(nxt);
            if constexpr (SP2) {
            PG8_LDB(B0, 0, 0); PG8_LDB(B1, 0, 1); PG8_SCHED; PG8_LDA(At, 0, 0); PG8_STAGE(PG8_SA(1, 1), a1 + hstepA, voffA);
            PG8_WAIT_V(8); PG8_WAIT_L(0); PG8_BAR; PG8_MMA(0, 0, At, B0); PG8_MMA(0, 1, At, B1); PG8_BAR; PG8_SCHED;
            PG8_LDA(At, 0, 1); PG8_STAGE(PG8_SB(0, 0), b2, voffB); PG8_STAGE(PG8_SB(0, 1), b2 + hstep, voffB); PG8_STAGE(PG8_SA(0, 0), a2, voffA);
            PG8_WAIT_V(8); PG8_WAIT_L(0); PG8_BAR; PG8_MMA(1, 0, At, B0); PG8_MMA(1, 1, At, B1); PG8_BAR; PG8_SCHED;
            PG8_LDB(B0, 1, 0); PG8_LDB(B1, 1, 1); PG8_SCHED; PG8_LDA(At, 1, 0); PG8_STAGE(PG8_SA(0, 1), a2 + hstepA, voffA);
            PG8_WAIT_V(8); PG8_WAIT_L(0); PG8_BAR; PG8_MMA(0, 0, At, B0); PG8_MMA(0, 1, At, B1); PG8_BAR; PG8_SCHED;
            PG8_LDA(At, 1, 1); PG8_STAGE(PG8_SB(1, 0), b3, voffB); PG8_STAGE(PG8_SB(1, 1), b3 + hstep, voffB); PG8_STAGE(PG8_SA(1, 0), a3, voffA);
            PG8_WAIT_V(8); PG8_WAIT_L(0); PG8_BAR; PG8_MMA(1, 0, At, B0); PG8_MMA(1, 1, At, B1); PG8_BAR; PG8_SCHED;
            } else {
            PG8_LDB(B0, 0, 0); PG8_SCHED; PG8_LDA(At, 0, 0); PG8_STAGE(PG8_SA(1, 1), a1 + hstepA, voffA);
            PG8_WAIT_L(8); PG8_BAR; PG8_WAIT_L(0); PG8_MMA(0, 0, At, B0); PG8_BAR; PG8_SCHED;
            PG8_LDB(B1, 0, 1); PG8_STAGE(PG8_SB(0, 0), b2, voffB);
            PG8_BAR; PG8_WAIT_L(0); PG8_MMA(0, 1, At, B1); PG8_BAR;
            PG8_LDA(At, 0, 1); PG8_STAGE(PG8_SA(0, 0), a2, voffA);
            PG8_BAR; PG8_WAIT_L(0); PG8_MMA(1, 0, At, B0); PG8_BAR; PG8_SCHED;
            PG8_STAGE(PG8_SB(0, 1), b2 + hstep, voffB);
            PG8_WAIT_V(6); PG8_BAR; PG8_MMA(1, 1, At, B1); PG8_BAR;
            PG8_LDB(B0, 1, 0); PG8_SCHED; PG8_LDA(At, 1, 0); PG8_STAGE(PG8_SA(0, 1), a2 + hstepA, voffA);
            PG8_WAIT_L(8); PG8_BAR; PG8_WAIT_L(0); PG8_MMA(0, 0, At, B0); PG8_BAR; PG8_SCHED;
            PG8_LDB(B1, 1, 1); PG8_STAGE(PG8_SB(1, 0), b3, voffB);
            PG8_BAR; PG8_WAIT_L(0); PG8_MMA(0, 1, At, B1); PG8_BAR;
            PG8_LDA(At, 1, 1); PG8_STAGE(PG8_SA(1, 0), a3, voffA);
            PG8_BAR; PG8_WAIT_L(0); PG8_MMA(1, 0, At, B0); PG8_BAR; PG8_SCHED;
            PG8_STAGE(PG8_SB(1, 1), b3 + hstep, voffB);
            PG8_WAIT_V(6); PG8_BAR; PG8_MMA(1, 1, At, B1); PG8_BAR;
            }
        }
        if constexpr (ALIGN_EPI) { if (wr == 0) PG8_BAR; }
        if constexpr (!Epi::AFTER_DRAIN) { if (cur.pm != est_pm) { E.prep(est, cur, wr, fr); est_pm = cur.pm; } E(acc, cur, wr, wc, fr, fq, est); S.done(cur); }
        if (!has_next) break;
#pragma unroll
        for (int a = 0; a < 2; ++a)
#pragma unroll
            for (int b = 0; b < 2; ++b)
#pragma unroll
                for (int m = 0; m < 4; ++m)
#pragma unroll
                    for (int n = 0; n < 2; ++n) acc[a][b][m][n] = (f32x4){0.f, 0.f, 0.f, 0.f};
        cur = nxt; cA = nA; cB = nB; ++ui;
        if constexpr (ALIGN_EPI) { if (wr == 1) PG8_BAR; }
    }
    PG8_WAIT_V(0);
    if constexpr (!ALIGN_EPI) { if (wr == 0) PG8_BAR; }
    PG8_BAR;
    if constexpr (Epi::AFTER_DRAIN) { E.fused(acc, cur, wr, wc, fr, fq, lds, wid, lane); S.done(cur); }
    (void)est_pm;
#undef PG8_SA
#undef PG8_SB
#undef PG8_STAGE
#undef PG8_LDA
#undef PG8_LDB
#undef PG8_MMA
#undef PG8_WAIT_V
#undef PG8_WAIT_L
#undef PG8_BAR
#undef PG8_SCHED
}
}
namespace att {
typedef unsigned short bf16;
typedef short bf16x8 __attribute__((ext_vector_type(8)));
typedef short s16x4 __attribute__((ext_vector_type(4)));
typedef float f32x16 __attribute__((ext_vector_type(16)));
typedef float f32x4 __attribute__((ext_vector_type(4)));
typedef unsigned u32x4 __attribute__((ext_vector_type(4)));
constexpr int D = 128, NW = 8, QBLK = 32, KVBLK = 64, QB = NW * QBLK;
constexpr int SHM_V = KVBLK * D * 2, SHM_K = KVBLK * D * 2;
constexpr int LDS_WS = 131072 + 512, LUTS = 160, LDS_LUT = LDS_WS + NW * 64 * 4, LDS_BND = LDS_LUT + 32 * LUTS * 4, LDS_BYTES = LDS_BND + 32 * 4;
#define KSWZ(row, colB) ((row) * 256 + ((colB) ^ (((row) & 7) << 4)))
#define SBAR() __builtin_amdgcn_sched_barrier(0)
__device__ __forceinline__ int v_st(int k, int c) { const int kk = (k & ~0xC) | ((k & 4) << 1) | ((k & 8) >> 1); return ((kk >> 3) * 4 + (c >> 5)) * 512 + ((kk & 7) * 32 + (c & 31)) * 2; }
__device__ __forceinline__ int v_rd_base(int lane) { return ((lane & 3) << 3) | (((lane >> 2) & 3) << 6) | (((lane >> 4) & 1) << 5) | (((lane >> 5) & 1) << 8); }
constexpr int v_rd_off(int d0, int ks, int half) { return d0 * 512 + ks * 4096 + half * 2048; }
__device__ __forceinline__ int crow(int r, int hi) { return (r & 3) + 8 * (r >> 2) + 4 * hi; }
__device__ __forceinline__ unsigned cvtpk(float lo, float hi) { unsigned r; asm volatile("v_cvt_pk_bf16_f32 %0, %1, %2" : "=v"(r) : "v"(lo), "v"(hi)); return r; }
__device__ __forceinline__ bf16x8 load8(const bf16* p) { return *reinterpret_cast<const bf16x8*>(p); }
__device__ __forceinline__ void bias_mask_tile(f32x16& p0, f32x16& p1, int dq, unsigned W, const float* lut) {
#pragma unroll
    for (int r = 0; r < 16; ++r) {
        const int c = (r & 3) + 8 * (r >> 2);
        const int d0 = dq - c, d1 = dq - c - 32;
        const int i0 = ((unsigned)d0 >= W) ? 128 : (d0 > 127 ? 127 : d0), i1 = ((unsigned)d1 >= W) ? 128 : (d1 > 127 ? 127 : d1);
        p0[r] += lut[i0]; p1[r] += lut[i1];
    }
}
__device__ __forceinline__ void partialSM(f32x16& p0) {
#pragma unroll
    for (int r = 0; r < 16; ++r) p0[r] = __builtin_amdgcn_exp2f(p0[r]);
}
__device__ __forceinline__ void finishSM(f32x16& p0, f32x16& p1, float& l_reg, bf16x8& pa0, bf16x8& pa1, bf16x8& pa2, bf16x8& pa3) {
#pragma unroll
    for (int r = 0; r < 16; ++r) p1[r] = __builtin_amdgcn_exp2f(p1[r]);
    float ps = 0;
#pragma unroll
    for (int r = 0; r < 16; ++r) ps += p0[r];
#pragma unroll
    for (int r = 0; r < 16; ++r) ps += p1[r];
    { auto rr = __builtin_amdgcn_permlane32_swap(__float_as_uint(ps), __float_as_uint(ps), false, false);
      ps = __uint_as_float(rr[0]) + __uint_as_float(rr[1]); }
    l_reg += ps;
#define PK4(P, B_, OUT) do { unsigned a0 = cvtpk(P[B_+0], P[B_+1]), a1 = cvtpk(P[B_+2], P[B_+3]);                          \
        unsigned b0 = cvtpk(P[B_+4], P[B_+5]), b1 = cvtpk(P[B_+6], P[B_+7]);                                             \
        auto r0 = __builtin_amdgcn_permlane32_swap(a0, b0, false, false); auto r1 = __builtin_amdgcn_permlane32_swap(a1, b1, false, false); \
        u32x4 w = {r0[0], r1[0], r0[1], r1[1]}; OUT = *reinterpret_cast<bf16x8*>(&w); } while (0)
    PK4(p0, 0, pa0); PK4(p0, 8, pa1); PK4(p1, 0, pa2); PK4(p1, 8, pa3);
#undef PK4
}
template <bool SK>
__device__ __forceinline__ void qkt(f32x16& p0, f32x16& p1, const char* K_lds, int r32, int hi, const bf16x8* qr, bool act, float binit) {
    if (SK && !act) { const float NEG = -__builtin_inff();
#pragma unroll
        for (int r = 0; r < 16; ++r) { p0[r] = NEG; p1[r] = NEG; } return; }
#pragma unroll
    for (int r = 0; r < 16; ++r) { p0[r] = binit; p1[r] = binit; }
    const char* kb[4];
#pragma unroll
    for (int dd = 0; dd < 4; ++dd) kb[dd] = K_lds + KSWZ(r32, (dd * 16 + hi * 8) * 2);
#pragma unroll
    for (int d0 = 0; d0 < 8; ++d0) { const char* a = kb[d0 & 3] + (d0 >> 2) * 128;
        bf16x8 b0 = *reinterpret_cast<const bf16x8*>(a);
        bf16x8 b1 = *reinterpret_cast<const bf16x8*>(a + 32 * 256);
        p0 = __builtin_amdgcn_mfma_f32_32x32x16_bf16(b0, qr[d0], p0, 0, 0, 0);
        p1 = __builtin_amdgcn_mfma_f32_32x32x16_bf16(b1, qr[d0], p1, 0, 0, 0); }
}
template <bool SK>
__device__ __forceinline__ void pv_tile(f32x16* o, int vb0, bf16x8 pa0, bf16x8 pa1, bf16x8 pa2, bf16x8 pa3, bool act) {
    if (SK && !act) return;
#define TRRD(dst, off) asm volatile("ds_read_b64_tr_b16 %0, %1 offset:%2" : "=&v"(dst) : "v"(vb0), "i"(off) : "memory")
#define PV_D0(d0) do { s16x4 l0, l1, l2, l3, h0, h1, h2, h3; constexpr int b_ = v_rd_off(d0, 0, 0); \
        TRRD(l0, b_); TRRD(h0, b_ + 2048); TRRD(l1, b_ + 4096); TRRD(h1, b_ + 6144); TRRD(l2, b_ + 8192); TRRD(h2, b_ + 10240); TRRD(l3, b_ + 12288); TRRD(h3, b_ + 14336); \
        asm volatile("s_waitcnt lgkmcnt(0)" ::: "memory"); SBAR();   \
        o[d0] = __builtin_amdgcn_mfma_f32_32x32x16_bf16(pa0, (bf16x8){l0[0], l0[1], l0[2], l0[3], h0[0], h0[1], h0[2], h0[3]}, o[d0], 0, 0, 0);   \
        o[d0] = __builtin_amdgcn_mfma_f32_32x32x16_bf16(pa1, (bf16x8){l1[0], l1[1], l1[2], l1[3], h1[0], h1[1], h1[2], h1[3]}, o[d0], 0, 0, 0);   \
        o[d0] = __builtin_amdgcn_mfma_f32_32x32x16_bf16(pa2, (bf16x8){l2[0], l2[1], l2[2], l2[3], h2[0], h2[1], h2[2], h2[3]}, o[d0], 0, 0, 0);   \
        o[d0] = __builtin_amdgcn_mfma_f32_32x32x16_bf16(pa3, (bf16x8){l3[0], l3[1], l3[2], l3[3], h3[0], h3[1], h3[2], h3[3]}, o[d0], 0, 0, 0); } while (0)
    PV_D0(0); PV_D0(1); PV_D0(2); PV_D0(3);
#undef PV_D0
#undef TRRD
}
__device__ __forceinline__ void pv256(f32x16* o, int vb0, bf16x8 pa0, bf16x8 pa1, bf16x8 pa2, bf16x8 pa3) {
#define TRRD(dst, off) asm volatile("ds_read_b64_tr_b16 %0, %1 offset:%2" : "=&v"(dst) : "v"(vb0), "i"(off) : "memory")
#define RD8(S, d) do { constexpr int b_ = ((d) >> 2) * 16384 + v_rd_off((d) & 3, 0, 0); \
        TRRD(S##l0, b_); TRRD(S##h0, b_ + 2048); TRRD(S##l1, b_ + 4096); TRRD(S##h1, b_ + 6144); TRRD(S##l2, b_ + 8192); TRRD(S##h2, b_ + 10240); TRRD(S##l3, b_ + 12288); TRRD(S##h3, b_ + 14336); } while (0)
#define MM4(S, d) do { \
        o[d] = __builtin_amdgcn_mfma_f32_32x32x16_bf16(pa0, (bf16x8){S##l0[0], S##l0[1], S##l0[2], S##l0[3], S##h0[0], S##h0[1], S##h0[2], S##h0[3]}, o[d], 0, 0, 0);   \
        o[d] = __builtin_amdgcn_mfma_f32_32x32x16_bf16(pa1, (bf16x8){S##l1[0], S##l1[1], S##l1[2], S##l1[3], S##h1[0], S##h1[1], S##h1[2], S##h1[3]}, o[d], 0, 0, 0);   \
        o[d] = __builtin_amdgcn_mfma_f32_32x32x16_bf16(pa2, (bf16x8){S##l2[0], S##l2[1], S##l2[2], S##l2[3], S##h2[0], S##h2[1], S##h2[2], S##h2[3]}, o[d], 0, 0, 0);   \
        o[d] = __builtin_amdgcn_mfma_f32_32x32x16_bf16(pa3, (bf16x8){S##l3[0], S##l3[1], S##l3[2], S##l3[3], S##h3[0], S##h3[1], S##h3[2], S##h3[3]}, o[d], 0, 0, 0); } while (0)
#define WAITL(n) do { asm volatile("s_waitcnt lgkmcnt(" #n ")" ::: "memory"); SBAR(); } while (0)
    s16x4 Al0, Al1, Al2, Al3, Ah0, Ah1, Ah2, Ah3, Bl0, Bl1, Bl2, Bl3, Bh0, Bh1, Bh2, Bh3;
    RD8(A, 0);
    RD8(B, 1); WAITL(8); MM4(A, 0);
    RD8(A, 2); WAITL(8); MM4(B, 1);
    RD8(B, 3); WAITL(8); MM4(A, 2);
    RD8(A, 4); WAITL(8); MM4(B, 3);
    RD8(B, 5); WAITL(8); MM4(A, 4);
    RD8(A, 6); WAITL(8); MM4(B, 5);
    RD8(B, 7); WAITL(8); MM4(A, 6);
    WAITL(0); MM4(B, 7);
#undef TRRD
#undef RD8
#undef MM4
#undef WAITL
}
typedef __amdgpu_buffer_rsrc_t rsrc_t;
#define LASV __attribute__((address_space(3))) void
__device__ __forceinline__ bf16x8 bload8(rsrc_t rs, unsigned voff, unsigned soff) { return __builtin_bit_cast(bf16x8, __builtin_amdgcn_raw_buffer_load_b128(rs, voff, soff, 0)); }
struct BlockRef { unsigned Q, K, V; bf16* O; int P0; int map; float sink2; };
struct Seam { bf16x8 qr[8]; int slot; };
struct Stg { unsigned k0, k1, v0, v1; };
__device__ __forceinline__ int swa_jlo(int P0, int W) { const int lowk = P0 - W + 1; return lowk > 0 ? lowk / KVBLK : 0; }
#define LASU __attribute__((address_space(3))) unsigned
#define VMW() asm volatile("s_waitcnt vmcnt(0)" ::: "memory")
#define VMWN(n) asm volatile("s_waitcnt vmcnt(%0)" :: "i"(n) : "memory")
template <int LDQK>
__device__ __forceinline__ Stg make_stg(int wid, int lane) {
    Stg g;
    { const int s = wid * 2, row = s * 4 + (lane >> 4), cc = lane & 15; g.k0 = (unsigned)(row * LDQK + ((cc ^ (row & 7)) * 8)) * 2u; }
    { const int s = wid * 2 + 1, row = s * 4 + (lane >> 4), cc = lane & 15; g.k1 = (unsigned)(row * LDQK + ((cc ^ (row & 7)) * 8)) * 2u; }
    { const int s = wid * 2, kk = (s >> 1) * 8 + ((lane >> 2) & 7), c = ((s & 1) * 2 + (lane >> 5)) * 32 + (lane & 3) * 8, k = (kk & ~0xC) | ((kk & 4) << 1) | ((kk & 8) >> 1); g.v0 = (unsigned)(k * LDQK + c) * 2u; }
    { const int s = wid * 2 + 1, kk = (s >> 1) * 8 + ((lane >> 2) & 7), c = ((s & 1) * 2 + (lane >> 5)) * 32 + (lane & 3) * 8, k = (kk & ~0xC) | ((kk & 4) << 1) | ((kk & 8) >> 1); g.v1 = (unsigned)(k * LDQK + c) * 2u; }
    return g;
}
template <int LDQK>
__device__ __forceinline__ void dma_tile(rsrc_t rs, unsigned Kh, unsigned Vh, int kbase, int slot, char* lds, int wid, const Stg& g) {
    const unsigned ko = Kh + (unsigned)kbase * (LDQK * 2u), vo = Vh + (unsigned)kbase * (LDQK * 2u);
    char* kd = lds + 3 * SHM_V + slot * SHM_K + wid * 2048; char* vd = lds + slot * SHM_V + wid * 2048;
    __builtin_amdgcn_raw_ptr_buffer_load_lds(rs, (LASV*)kd, 16, g.k0, ko, 0, 0);
    __builtin_amdgcn_raw_ptr_buffer_load_lds(rs, (LASV*)(kd + 1024), 16, g.k1, ko, 0, 0);
    __builtin_amdgcn_raw_ptr_buffer_load_lds(rs, (LASV*)vd, 16, g.v0, vo, 0, 0);
    __builtin_amdgcn_raw_ptr_buffer_load_lds(rs, (LASV*)(vd + 1024), 16, g.v1, vo, 0, 0);
}
template <int LDQK>
__device__ __forceinline__ void attn_prime(rsrc_t rs, const BlockRef& cur, int W, char* lds, Seam& S, const Stg& g, int tid) {
    const int wid = __builtin_amdgcn_readfirstlane(tid >> 6), lane = tid & 63, r32 = lane & 31, hi = lane >> 5;
    S.slot = 0;
    dma_tile<LDQK>(rs, cur.K, cur.V, swa_jlo(cur.P0, W) * KVBLK, 0, lds, wid, g);
#pragma unroll
    for (int d0 = 0; d0 < 8; ++d0) S.qr[d0] = bload8(rs, (unsigned)((wid * QBLK + r32) * LDQK + hi * 8) * 2u + d0 * 32, cur.Q);
    VMW(); __syncthreads();
}
template <int LDQK, int LDO>
__device__ __forceinline__ void attn_block(rsrc_t rs, const BlockRef& cur, const BlockRef& nxt, int skv, int W, char* lds, Seam& S, const Stg& g, int tid) {
    constexpr bool SK = true;
    const int wid = __builtin_amdgcn_readfirstlane(tid >> 6), lane = tid & 63, r32 = lane & 31, hi = lane >> 5;
    const int j_lo = swa_jlo(cur.P0, W);
    int j_hi = (cur.P0 + QB - 1) / KVBLK + 1; if (j_hi > skv / KVBLK) j_hi = skv / KVBLK;
    const int NT = j_hi - j_lo;
    const int kbn = swa_jlo(nxt.P0, W) * KVBLK;
    const int qlo = cur.P0 + wid * QBLK, qm = qlo + r32 - 4 * hi;
    char* V_lds = lds; char* K_lds = lds + 3 * SHM_V;
    float* ws = (float*)(lds + LDS_WS) + wid * 64; float* li_l = ws; const float* bnd = (const float*)(lds + LDS_BND);
    const float* lut = (const float*)(lds + LDS_LUT) + cur.map * LUTS;
    const float cfar = __builtin_bit_cast(float, __builtin_amdgcn_readfirstlane(__builtin_bit_cast(int, lut[127])));
    float l_reg = 0; f32x16 o[4] = {};
    const int vb0 = (int)(uintptr_t)V_lds + v_rd_base(lane);
    const unsigned Kh = cur.K, Vh = cur.V;
    int sl = S.slot;
#define NEXT(s) ((s) == 2 ? 0 : (s) + 1)
#define PREV(s) ((s) == 0 ? 2 : (s) - 1)
#define KBASE(t) ((j_lo + (t)) * KVBLK)
#define ACT(t) (KBASE(t) <= qlo + QBLK - 1 && KBASE(t) + KVBLK - 1 >= qlo - W + 1)
#define FIX(t) (KBASE(t) + KVBLK + 126 > qlo || KBASE(t) <= qlo + QBLK - 1 - W)
#define BINIT(t) (FIX(t) ? 0.f : cfar)
#define MASKT(P0_, P1_, t) do { const int kb_ = KBASE(t); if ((!SK || ACT(t)) && FIX(t)) bias_mask_tile(P0_, P1_, qm - kb_, (unsigned)W, lut); } while (0)
    f32x16 pA0, pA1, pB0, pB1; bf16x8 pa0, pa1, pa2, pa3;
    if (NT > 1) dma_tile<LDQK>(rs, Kh, Vh, KBASE(1), NEXT(sl), lds, wid, g);
    SBAR(); qkt<SK>(pA0, pA1, K_lds + sl * SHM_K, r32, hi, S.qr, ACT(0), BINIT(0));
    MASKT(pA0, pA1, 0); partialSM(pA0);
    VMW(); __syncthreads();
    sl = NEXT(sl);
#define HALF_STEP(PX0, PX1, PY0, PY1, t) do {                                                                  \
        if ((t) + 1 < NT) dma_tile<LDQK>(rs, Kh, Vh, KBASE((t) + 1), NEXT(sl), lds, wid, g);                                      \
        SBAR(); qkt<SK>(PX0, PX1, K_lds + sl * SHM_K, r32, hi, S.qr, ACT(t), BINIT(t));                                       \
        finishSM(PY0, PY1, l_reg, pa0, pa1, pa2, pa3); SBAR();                                                                \
        pv_tile<SK>(o, vb0 + PREV(sl) * SHM_V, pa0, pa1, pa2, pa3, ACT((t) - 1)); MASKT(PX0, PX1, (t)); partialSM(PX0); \
        VMW(); __syncthreads();                                                                                               \
        sl = NEXT(sl); } while (0)
    int t = 1;
    for (; t + 1 < NT; t += 2) {
        HALF_STEP(pB0, pB1, pA0, pA1, t);
        HALF_STEP(pA0, pA1, pB0, pB1, t + 1);
    }
    const bool even = (NT & 1) == 0;
    if (even) { SBAR(); qkt<SK>(pB0, pB1, K_lds + sl * SHM_K, r32, hi, S.qr, ACT(NT - 1), BINIT(NT - 1)); SBAR(); sl = NEXT(sl); }
    dma_tile<LDQK>(rs, nxt.K, nxt.V, kbn, sl, lds, wid, g); SBAR();
#pragma unroll
    for (int d0 = 0; d0 < 8; ++d0) S.qr[d0] = bload8(rs, (unsigned)((wid * QBLK + r32) * LDQK + hi * 8) * 2u + d0 * 32, nxt.Q);
    SBAR();
    S.slot = sl;
    finishSM(pA0, pA1, l_reg, pa0, pa1, pa2, pa3); SBAR();
    pv_tile<SK>(o, vb0 + (even ? PREV(PREV(sl)) : PREV(sl)) * SHM_V, pa0, pa1, pa2, pa3, ACT(even ? NT - 2 : NT - 1));
    if (even) { MASKT(pB0, pB1, NT - 1); partialSM(pB0);
        finishSM(pB0, pB1, l_reg, pa0, pa1, pa2, pa3); SBAR(); pv_tile<SK>(o, vb0 + PREV(sl) * SHM_V, pa0, pa1, pa2, pa3, ACT(NT - 1)); }
    SBAR(); VMWN(8); SBAR();
    if (hi == 0) li_l[r32] = l_reg + __builtin_amdgcn_exp2f(cur.sink2 - bnd[cur.map]);
    asm volatile("s_waitcnt lgkmcnt(0)" ::: "memory");
    float rli[16];
#pragma unroll
    for (int r = 0; r < 16; ++r) rli[r] = __builtin_amdgcn_rcpf(li_l[crow(r, hi)]);
    bf16* Ow = cur.O + (size_t)(wid * QBLK) * LDO;
#pragma unroll
    for (int r = 0; r < 16; ++r) { const int orow = crow(r, hi);
#pragma unroll
        for (int d0 = 0; d0 < 4; ++d0) { const float v = o[d0][r] * rli[r];
            const float vn = shflx(v, 1, lane);
            if ((r32 & 1) == 0) *(unsigned*)(Ow + (size_t)orow * LDO + d0 * 32 + r32) = cvtpk(v, vn); } }
    __syncthreads();
#undef KBASE
#undef ACT
#undef FIX
#undef BINIT
#undef MASKT
#undef HALF_STEP
#undef NEXT
#undef PREV
}
#undef VMW
#undef VMWN
#undef LASU

struct Block2 { unsigned Q, K, V; bf16* O; int P0; int map0; int rev; };
struct Seam2 { bf16x8 qr[8]; int st; };
constexpr int ST2 = 65536;
#define LASU __attribute__((address_space(3))) unsigned
#define VMW() asm volatile("s_waitcnt vmcnt(0)" ::: "memory")
#define VMWN(n) asm volatile("s_waitcnt vmcnt(%0)" :: "i"(n) : "memory")
template <int LD>
__device__ __forceinline__ void dma_k2(rsrc_t rs, unsigned Kb, int kbase, int st, char* lds, int wid, const Stg& g) {
    const unsigned so = Kb + (unsigned)kbase * (LD * 2u); char* d = lds + st * ST2 + wid * 2048;
    __builtin_amdgcn_raw_ptr_buffer_load_lds(rs, (LASV*)d, 16, g.k0, so, 0, 0);
    __builtin_amdgcn_raw_ptr_buffer_load_lds(rs, (LASV*)(d + 1024), 16, g.k1, so, 0, 0);
    __builtin_amdgcn_raw_ptr_buffer_load_lds(rs, (LASV*)(d + 16384), 16, g.k0, so + 256u, 0, 0);
    __builtin_amdgcn_raw_ptr_buffer_load_lds(rs, (LASV*)(d + 16384 + 1024), 16, g.k1, so + 256u, 0, 0);
}
template <int LD>
__device__ __forceinline__ void dma_v2(rsrc_t rs, unsigned Vb, int kbase, int st, char* lds, int wid, const Stg& g) {
    const unsigned so = Vb + (unsigned)kbase * (LD * 2u); char* d = lds + st * ST2 + wid * 2048;
    __builtin_amdgcn_raw_ptr_buffer_load_lds(rs, (LASV*)(d + 32768), 16, g.v0, so, 0, 0);
    __builtin_amdgcn_raw_ptr_buffer_load_lds(rs, (LASV*)(d + 32768 + 1024), 16, g.v1, so, 0, 0);
    __builtin_amdgcn_raw_ptr_buffer_load_lds(rs, (LASV*)(d + 49152), 16, g.v0, so + 256u, 0, 0);
    __builtin_amdgcn_raw_ptr_buffer_load_lds(rs, (LASV*)(d + 49152 + 1024), 16, g.v1, so + 256u, 0, 0);
}
template <int LD>
__device__ __forceinline__ void attn2_prime(rsrc_t rs, const Block2& cur, char* lds, Seam2& S, const Stg& g, int tid) {
    const int wid = __builtin_amdgcn_readfirstlane(tid >> 6), lane = tid & 63, r32 = lane & 31, hi = lane >> 5, ms = wid >> 2, rg = wid & 3;
    S.st = 0;
    const int ft = cur.rev ? (cur.P0 + 127) / KVBLK : 0;
    dma_k2<LD>(rs, cur.K, ft * KVBLK, 0, lds, wid, g); dma_v2<LD>(rs, cur.V, ft * KVBLK, 0, lds, wid, g);
    const unsigned ql = (unsigned)((rg * QBLK + r32) * LD + ms * 128 + hi * 8) * 2u;
#pragma unroll
    for (int d0 = 0; d0 < 8; ++d0) S.qr[d0] = bload8(rs, ql + d0 * 32, cur.Q);
    VMW(); __syncthreads();
}
template <int LD, int LDO, class RefFn>
__device__ __forceinline__ int attn2_block(rsrc_t rs, const Block2& cur, unsigned* qctr, volatile __attribute__((address_space(3))) unsigned* slot, int QN, RefFn ref, char* lds, Seam2& S, const Stg& g, int tid, float lam, const float* g_sub, float osc, float eps) {
    const int wid = __builtin_amdgcn_readfirstlane(tid >> 6), lane = tid & 63, ms = wid >> 2, rg = wid & 3;
    float l_reg = 0; f32x16 o[8] = {}; bf16x8 pa0, pa1, pa2, pa3;
    int st = S.st;
    Block2 nxt = cur; int jnx = QN;
    {
    const int r32 = lane & 31, hi = lane >> 5;
    const int NT = (cur.P0 + 127) / KVBLK + 1;
    const int tbase = cur.rev ? NT - 1 : 0, tstep = cur.rev ? -1 : 1; int nft = 0;
    const int qlo = cur.P0 + rg * QBLK, qm = qlo + r32 - 4 * hi;
    const float* lut = (const float*)(lds + LDS_LUT) + (cur.map0 + ms) * LUTS;
    const float cfar = __builtin_bit_cast(float, __builtin_amdgcn_readfirstlane(__builtin_bit_cast(int, lut[127])));
    const int s0 = st;
#define ISSUE_K(tt) do { if ((tt) < NT) dma_k2<LD>(rs, cur.K, (tbase + (tt) * tstep) * KVBLK, (s0 + (tt)) & 1, lds, wid, g); else dma_k2<LD>(rs, nxt.K, nft * KVBLK, (s0 + (tt)) & 1, lds, wid, g); } while (0)
#define ISSUE_V(tt) do { if ((tt) < NT) dma_v2<LD>(rs, cur.V, (tbase + (tt) * tstep) * KVBLK, (s0 + (tt)) & 1, lds, wid, g); else dma_v2<LD>(rs, nxt.V, nft * KVBLK, (s0 + (tt)) & 1, lds, wid, g); } while (0)
#define LOAD_NEXT_Q() do { SBAR(); const unsigned ql = (unsigned)((rg * QBLK + r32) * LD + ms * 128 + hi * 8) * 2u; _Pragma("unroll") for (int d0 = 0; d0 < 8; ++d0) S.qr[d0] = bload8(rs, ql + d0 * 32, nxt.Q); SBAR(); } while (0)
#define QKT_SM(t) do { const int sg = (s0 + (t)) & 1, kb = (tbase + (t) * tstep) * KVBLK; const bool fix = kb + KVBLK + 126 > qlo;     \
        int lx = lane; asm volatile("" : "+v"(lx)); const int r32x = lx & 31, hix = lx >> 5;     \
        f32x16 p0, p1; SBAR(); __builtin_amdgcn_s_setprio(2); qkt<false>(p0, p1, lds + sg * ST2 + ms * 16384, r32x, hix, S.qr, true, fix ? 0.f : cfar);     \
        if (fix) bias_mask_tile(p0, p1, qlo + r32x - 4 * hix - kb, 1u << 30, lut); \
        partialSM(p0); finishSM(p0, p1, l_reg, pa0, pa1, pa2, pa3); __builtin_amdgcn_s_setprio(0); SBAR(); } while (0)
#define PV(t) do { int lx = lane; asm volatile("" : "+v"(lx)); const int vb = (int)(uintptr_t)(lds + ((s0 + (t)) & 1) * ST2 + 32768) + v_rd_base(lx); SBAR(); \
        pv256(o, vb, pa0, pa1, pa2, pa3); SBAR(); } while (0)
#define HS_END(all) do { if (all) asm volatile("s_waitcnt vmcnt(0) lgkmcnt(0)" ::: "memory"); else asm volatile("s_waitcnt vmcnt(4) lgkmcnt(0)" ::: "memory"); \
        __builtin_amdgcn_s_barrier(); asm volatile("" ::: "memory"); } while (0)
#define FETCH_NEXT() do { jnx = __builtin_amdgcn_readfirstlane((int)*slot); if (jnx < QN) { ref(jnx, nxt); nft = nxt.rev ? (nxt.P0 + 127) / KVBLK : 0; } } while (0)
    if (ms == 0) {
#pragma nounroll
        for (int t = 0; t < NT; ++t) { const bool lastt = t + 1 == NT, claim = t + 2 == NT;
            if (lastt) FETCH_NEXT();
            ISSUE_K(t + 1); QKT_SM(t); HS_END(false);
            unsigned gq = 0;
            if (claim && tid == 0) gq = __hip_atomic_fetch_add(qctr, 1u, __ATOMIC_RELAXED, __HIP_MEMORY_SCOPE_AGENT);
            ISSUE_V(t + 1); PV(t);
            if (claim) { VMWN(4); if (tid == 0) *slot = gq; }
            HS_END(lastt); }
        HS_END(true);
    } else {
        ISSUE_K(1); HS_END(false);
#pragma nounroll
        for (int t = 0; t < NT; ++t) { const bool lastt = t + 1 == NT;
            ISSUE_V(t + 1); QKT_SM(t); HS_END(lastt);
            if (!lastt) { if (t + 2 == NT) FETCH_NEXT(); ISSUE_K(t + 2); }
            PV(t); HS_END(lastt); }
    }
#undef FETCH_NEXT
    LOAD_NEXT_Q();
#undef ISSUE_K
#undef ISSUE_V
#undef LOAD_NEXT_Q
#undef QKT_SM
#undef PV
#undef HS_END
    st = (s0 + NT) & 1;
    }
    S.st = st;
    int lane_e = lane; asm volatile("" : "+v"(lane_e));
    const int r32 = lane_e & 31, hi = lane_e >> 5;
    float* li_l = (float*)(lds + LDS_WS) + wid * 64;
    if (hi == 0) li_l[r32] = l_reg;
    asm volatile("s_waitcnt lgkmcnt(0)" ::: "memory");
    unsigned short* xr = (unsigned short*)(lds + (st ^ 1) * ST2 + rg * 16384);
    if (ms == 1) {
#pragma unroll
        for (int r = 0; r < 16; ++r) { const int row = crow(r, hi); const float f = __builtin_amdgcn_rcpf(li_l[row]) * lam;
#pragma unroll
            for (int d0 = 0; d0 < 8; ++d0) xr[row * 256 + d0 * 32 + r32] = (unsigned short)cvtpk(o[d0][r] * f, 0.f);
            if ((r & 3) == 3) asm volatile("" ::: "memory"); }
    }
    asm volatile("s_waitcnt lgkmcnt(0)" ::: "memory");
    __syncthreads();
    if (ms == 0) {
        float gs[8];
#pragma unroll
        for (int d0 = 0; d0 < 8; ++d0) gs[d0] = g_sub[d0 * 32 + r32] * osc;
        float rlv[16], av[16];
#pragma unroll
        for (int r = 0; r < 16; ++r) rlv[r] = __builtin_amdgcn_rcpf(li_l[crow(r, hi)]);
#pragma unroll
        for (int r = 0; r < 16; ++r) { const int row = crow(r, hi); float a = 0.f;
#pragma unroll
            for (int d0 = 0; d0 < 8; ++d0) { const float x2 = __uint_as_float((unsigned)xr[row * 256 + d0 * 32 + r32] << 16); const float v = o[d0][r] * rlv[r] - x2; a += v * v; }
            av[r] = sum16(a); }
#pragma unroll
        for (int r = 0; r < 16; ++r) av[r] += swz16(av[r]);
#pragma unroll
        for (int r = 0; r < 16; ++r) av[r] = __builtin_amdgcn_rsqf(av[r] * (1.f / 256.f) + eps);
#pragma unroll
        for (int r = 0; r < 16; ++r) { const int row = crow(r, hi);
#pragma unroll
            for (int d0 = 0; d0 < 8; ++d0) { const float x2 = __uint_as_float((unsigned)xr[row * 256 + d0 * 32 + r32] << 16);
                xr[row * 256 + d0 * 32 + r32] = (unsigned short)cvtpk((o[d0][r] * rlv[r] - x2) * av[r] * gs[d0], 0.f); }
            if ((r & 3) == 3) asm volatile("" ::: "memory"); }
        asm volatile("s_waitcnt lgkmcnt(0)" ::: "memory");
        bf16* Ow = cur.O + (size_t)(rg * QBLK) * LDO;
#pragma unroll
        for (int j = 0; j < 16; ++j) { const int c = lane_e + 64 * j, row = c >> 5, cc = c & 31;
            *(u32x4*)(Ow + (size_t)row * LDO + cc * 8) = *(const u32x4*)(xr + row * 256 + cc * 8); }
    }
    __syncthreads();
    return jnx;
}
#undef VMW
#undef VMWN
#undef LASU
#undef LASV
}
constexpr int NWAVES = 8;
constexpr int BATCH = 2, SEQ = 8192, DM = 4096, M = BATCH * SEQ;
constexpr int DFF = 11008, NQKV = 3 * DM, NGU = 2 * DFF, NKVQ = 2048 + DM;
constexpr float EPS = 1e-6f, LOG2E = 1.4426950408889634f, QSCALE = 0.08838834764831845f * LOG2E;
constexpr float LAMBDA_INIT = 0.2f;
__device__ const unsigned char T5_BUCKET[128] = {0, 1, 2, 3, 4, 5, 6, 7, 8, 9, 10, 11, 12, 13, 14, 15, 16, 16, 16, 17, 17, 18, 18, 18, 19, 19, 19, 20, 20, 20, 20, 21, 21, 21, 21, 22, 22, 22, 22, 22, 23, 23, 23, 23, 23, 23, 24, 24, 24, 24, 24, 24, 25, 25, 25, 25, 25, 25, 25, 26, 26, 26, 26, 26, 26, 26, 26, 27, 27, 27, 27, 27, 27, 27, 27, 27, 27, 28, 28, 28, 28, 28, 28, 28, 28, 28, 28, 29, 29, 29, 29, 29, 29, 29, 29, 29, 29, 29, 29, 30, 30, 30, 30, 30, 30, 30, 30, 30, 30, 30, 30, 30, 30, 31, 31, 31, 31, 31, 31, 31, 31, 31, 31, 31, 31, 31, 31, 31};
constexpr size_t MiB = 1u << 20;
constexpr size_t WS_CTL = 0, CTL_ZERO_BYTES = 1 * MiB;
constexpr size_t SZ_WQKV = (size_t)NQKV * DM * 2, SZ_WSQ = (size_t)DM * DM * 2, SZ_WGU = (size_t)NGU * DM * 2, SZ_WD = (size_t)DM * DFF * 2, SZ_WKVQ = (size_t)NKVQ * DM * 2;
constexpr size_t WS_WQKV = 1 * MiB, WS_WOA = WS_WQKV + SZ_WQKV, WS_WGU0 = WS_WOA + SZ_WSQ, WS_WD0 = WS_WGU0 + SZ_WGU, WS_WKVQ = WS_WD0 + SZ_WD, WS_WOB = WS_WKVQ + SZ_WKVQ,
                 WS_WGU1 = WS_WOB + SZ_WSQ, WS_WD1 = WS_WGU1 + SZ_WGU, WS_WEND = WS_WD1 + SZ_WD;
constexpr size_t WS_H = WS_WEND;
constexpr size_t WS_R1 = WS_H + (size_t)M * DM * 2;
constexpr size_t WS_R2 = WS_R1 + (size_t)M * NQKV * 2;
constexpr size_t WS_XB = WS_R2 + (size_t)M * 8192 * 2;
constexpr size_t WS_END = WS_XB + (size_t)M * DM * 2;
constexpr size_t WS_SS = 262144;
constexpr int CW_TMO = 0, CW_CODE = 1, CW_BAR = 4096, CW_QUEUE = 8192;
#ifndef NCONV
#define NCONV 4
#endif
constexpr int RING_OFF = 0, RING_BYTES = 131072;
constexpr int LDSCTL_OFF = RING_BYTES, MISC_OFF = LDSCTL_OFF + 320;
constexpr int LDS_BYTES = 154624;
static_assert(att::LDS_BYTES <= LDS_BYTES && MISC_OFF + 128 <= att::LDS_WS, "LDS map");
#define GAS __attribute__((address_space(1)))
#define LAS __attribute__((address_space(3)))
typedef unsigned short bf16;
typedef unsigned v4u __attribute__((ext_vector_type(4)));
typedef float f32x4 __attribute__((ext_vector_type(4)));
typedef float f32x2 __attribute__((ext_vector_type(2)));
typedef short bf16x8 __attribute__((ext_vector_type(8)));
typedef GAS unsigned gu32;
typedef GAS unsigned long long gu64;
#define RLX_AGENT __ATOMIC_RELAXED, __HIP_MEMORY_SCOPE_AGENT
#define LDS_WAIT() asm volatile("s_waitcnt lgkmcnt(0)" ::: "memory")
#define VM_WAIT() asm volatile("s_waitcnt vmcnt(0)" ::: "memory")
__device__ __forceinline__ unsigned long long rt() { return __builtin_amdgcn_s_memrealtime(); }
__device__ __forceinline__ unsigned f2bf(float f) { unsigned u = __builtin_bit_cast(unsigned, f); return (u + 0x7fffu + ((u >> 16) & 1u)) >> 16; }
__device__ __forceinline__ unsigned pk2(float lo, float hi) { unsigned r; asm("v_cvt_pk_bf16_f32 %0, %1, %2" : "=v"(r) : "v"(lo), "v"(hi)); return r; }

#define XB_TMO      128
#define XB_XCNT(j)  (256  + 64 * (j))
#define XB_XSUB(j)  (1280 + 64 * (j))
#define XB_XGEN(j)  (2304 + 64 * (j))
#define XB_TOP      3328
#define XB_TOPGEN   3392
#define XCD_BAR_WORDS 3456
#define XB_SPIN_CAP (1u << 18)

__device__ __forceinline__ unsigned xb_ld(unsigned* p)              { return __hip_atomic_load(p, __ATOMIC_RELAXED, __HIP_MEMORY_SCOPE_AGENT); }
__device__ __forceinline__ unsigned xb_add(unsigned* p, unsigned v) { return __hip_atomic_fetch_add(p, v, __ATOMIC_RELAXED, __HIP_MEMORY_SCOPE_AGENT); }
__device__ __forceinline__ unsigned xb_xcc_id() { return (unsigned)__builtin_amdgcn_s_getreg((3 << 11) | 20) & 0xFu; }
#define XB_SPIN(cond, bar) do { unsigned _sp = 0; while (cond) { __builtin_amdgcn_s_sleep(1); \
    if ((++_sp & 255u) == 0u) { if (xb_ld(&(bar)[XB_TMO])) break; if (_sp > XB_SPIN_CAP) { atomicAdd(&(bar)[XB_TMO], 1u); break; } } } } while (0)

struct XcdBarrier {
    unsigned* bar; unsigned x;
    volatile LAS unsigned* st;
};

__device__ __forceinline__ XcdBarrier xcd_barrier_post(unsigned* bar, volatile LAS unsigned* st) {
    XcdBarrier b; b.bar = bar; b.x = xb_xcc_id(); b.st = st;
    if (threadIdx.x == 0) (void)xb_add(&bar[XB_XCNT(b.x)], 1u);
    return b;
}
__device__ __forceinline__ void xcd_barrier_complete(unsigned* bar, unsigned x, unsigned& nloc, unsigned& nx) {
    const unsigned G = gridDim.x * gridDim.y * gridDim.z;
    unsigned sum, cnt, mine, sp = 0u;
    for (;;) {
        sum = 0u; cnt = 0u; mine = 0u;
#pragma unroll
        for (unsigned j = 0; j < 16; ++j) { const unsigned c = xb_ld(&bar[XB_XCNT(j)]); sum += c; cnt += (c > 0u) ? 1u : 0u; }
        mine = xb_ld(&bar[XB_XCNT(x)]);
        if (sum == G) break;
        __builtin_amdgcn_s_sleep(1);
        if ((++sp & 255u) == 0u) { if (xb_ld(&bar[XB_TMO])) break; if (sp > XB_SPIN_CAP) { atomicAdd(&bar[XB_TMO], 1u); break; } }
    }
    nloc = mine > 0u ? mine : 1u; nx = cnt > 0u ? cnt : 1u;
}

__device__ __forceinline__ void xcd_barrier(const XcdBarrier& b) {
    asm volatile("s_waitcnt vmcnt(0)" ::: "memory");
    __syncthreads();
    if (threadIdx.x == 0) {
        unsigned* bar = b.bar; asm volatile("" : "+s"(bar));
        __builtin_amdgcn_s_waitcnt(0);
        unsigned nloc = b.st[0], nx = b.st[1];
        if (nloc == 0u) { xcd_barrier_complete(bar, b.x, nloc, nx); b.st[0] = nloc; b.st[1] = nx; }
        const unsigned old = xb_add(&bar[XB_XSUB(b.x)], 1u);
        const unsigned gen = old / nloc;
        if (old + 1u == (gen + 1u) * nloc) {
            __builtin_amdgcn_fence(__ATOMIC_RELEASE, "agent");
            asm volatile("s_waitcnt vmcnt(0)" ::: "memory");
            const unsigned og = xb_add(&bar[XB_TOP], 1u);
            const unsigned tg = og / nx;
            if (og + 1u == (tg + 1u) * nx) xb_add(&bar[XB_TOPGEN], 1u);
            else XB_SPIN(xb_ld(&bar[XB_TOPGEN]) == tg, bar);
            __builtin_amdgcn_fence(__ATOMIC_ACQUIRE, "agent");
            xb_add(&bar[XB_XGEN(b.x)], 1u);
            asm volatile("s_waitcnt vmcnt(0)" ::: "memory");
        } else {
            XB_SPIN(xb_ld(&bar[XB_XGEN(b.x)]) == gen, bar);
            __builtin_amdgcn_fence(__ATOMIC_ACQUIRE, "agent");
            asm volatile("s_waitcnt vmcnt(0)" ::: "memory");
        }
    }
    __syncthreads();
}
struct Args { const float* in[20]; float* out; unsigned char* ws; };
struct Frame {
    LAS unsigned char* lds; volatile LAS unsigned* MISC; gu32* ctl;
    int tid, lane, wave, vcu, G;
};
__device__ __forceinline__ float wave_sum(float v, int lane) { v = sum16(v); v += swz16(v); v += shflx(v, 32, lane); return v; }
struct TItem { const float* src; bf16* dst; const float* gain; int N, K; };
#define P0_LOAD(PRE_, T, v, g) do { if (PRE_) { if (T.gain) { _Pragma("unroll") for (int j_ = 0; j_ < 8; ++j_) g[j_] = *(const GAS f32x2*)(T.gain + 8 * j_ + 2 * (F.lane >> 4)); } else { _Pragma("unroll") for (int j_ = 0; j_ < 8; ++j_) g[j_] = (f32x2){1.f, 1.f}; } }     \
        _Pragma("unroll") for (int i_ = 0; i_ < 16; ++i_) v[i_] = __builtin_nontemporal_load((const GAS f32x4*)(T.src + (size_t)(8 * (i_ >> 1) + (i_ & 1)) * T.N)); } while (0)
template <bool PRE>
__device__ __forceinline__ void p0_process(const TItem& T, f32x4 (&v)[16], const f32x2 (&g)[8], LAS unsigned* scr, int lane) {
    const int q = lane & 15, s = lane >> 4;
    if constexpr (PRE) {
#pragma unroll
        for (int j = 0; j < 8; ++j) { v[2 * j] = v[2 * j] * g[j].x; v[2 * j + 1] = v[2 * j + 1] * g[j].y; }
    } else if (T.gain) {
#pragma unroll
        for (int i = 0; i < 16; ++i) { const float g = T.gain[8 * (i >> 1) + 2 * s + (i & 1)]; v[i] = v[i] * g; }
    }
#pragma unroll
    for (int p = 0; p < 8; ++p)
#pragma unroll
        for (int e = 0; e < 4; ++e) scr[(4 * q + e) * 33 + 4 * p + s] = pk2(v[2 * p][e], v[2 * p + 1][e]);
    LDS_WAIT(); asm volatile("" ::: "memory");
    const int c = lane & 7;
#pragma unroll
    for (int j = 0; j < 8; ++j) { const int n = (lane >> 3) + 8 * j; const LAS unsigned* r = scr + n * 33 + 4 * c;
        v4u o; o.x = r[0]; o.y = r[1]; o.z = r[2]; o.w = r[3];
        __builtin_nontemporal_store(o, (GAS v4u*)(T.dst + (size_t)n * T.K + 8 * c)); }
    LDS_WAIT(); asm volatile("" ::: "memory");
}
__device__ __forceinline__ void raw_rows(Frame& F, const float* X, bf16* XB, float* ss) {
    const int gw = F.vcu * NWAVES + F.wave, NGW = F.G * NWAVES;
    for (int m = gw; m < M; m += NGW) {
        const GAS f32x4* xr = (const GAS f32x4*)(X + (size_t)m * DM) + F.lane;
        f32x4 v[16]; float s = 0.f;
#pragma unroll
        for (int j = 0; j < 16; ++j) { v[j] = xr[64 * j]; s += (v[j].x * v[j].x + v[j].y * v[j].y) + (v[j].z * v[j].z + v[j].w * v[j].w); }
        s = wave_sum(s, F.lane);
        if (F.lane == 0) ss[m] = s;
        GAS unsigned long long* o8 = (GAS unsigned long long*)(XB + (size_t)m * DM) + F.lane;
#pragma unroll
        for (int j = 0; j < 16; ++j) o8[64 * j] = (unsigned long long)pk2(v[j].x, v[j].y) | ((unsigned long long)pk2(v[j].z, v[j].w) << 32);
    }
}
__device__ __forceinline__ void head_norm(Frame& F, bf16* T, int ld, int nchunk, int nA, int colA, int colB, const float* gA, float sA, const float* gB, float sB) {
    const int gw = F.vcu * NWAVES + F.wave, NGW = F.G * NWAVES;
    const int d0 = (F.lane & 15) * 8;
    float ga[8], gb[8];
#pragma unroll
    for (int e = 0; e < 8; ++e) { ga[e] = gA[d0 + e] * sA; gb[e] = gB[d0 + e] * sB; }
    const int total = M * nchunk;
    constexpr int U = 8;
    for (int base = gw; base < total; base += NGW * U) {
        v4u w[U]; GAS v4u* p[U]; bool isA[U];
#pragma unroll
        for (int u = 0; u < U; ++u) { int it = base + NGW * u; if (it >= total) it = total - 1; const int m = it / nchunk, c = it - m * nchunk; isA[u] = c < nA;
            p[u] = (GAS v4u*)(T + (size_t)m * ld + (isA[u] ? colA + 512 * c : colB + 512 * (c - nA)) + F.lane * 8); w[u] = *p[u]; }
#pragma unroll
        for (int u = 0; u < U; ++u) {
            float x[8];
            x[0] = __uint_as_float(w[u].x << 16); x[1] = __uint_as_float(w[u].x & 0xffff0000u); x[2] = __uint_as_float(w[u].y << 16); x[3] = __uint_as_float(w[u].y & 0xffff0000u);
            x[4] = __uint_as_float(w[u].z << 16); x[5] = __uint_as_float(w[u].z & 0xffff0000u); x[6] = __uint_as_float(w[u].w << 16); x[7] = __uint_as_float(w[u].w & 0xffff0000u);
            float s = 0.f;
#pragma unroll
            for (int e = 0; e < 8; ++e) s += x[e] * x[e];
            s += shflx(s, 1, F.lane); s += shflx(s, 2, F.lane); s += shflx(s, 4, F.lane); s += shflx(s, 8, F.lane);
            const float rstd = 1.0f / sqrtf(s * (1.f / 128.f) + EPS);
#pragma unroll
            for (int e = 0; e < 8; ++e) x[e] = x[e] * rstd * (isA[u] ? ga[e] : gb[e]);
            v4u o; o.x = pk2(x[0], x[1]); o.y = pk2(x[2], x[3]); o.z = pk2(x[4], x[5]); o.w = pk2(x[6], x[7]);
            if (base + NGW * u < total) *p[u] = o;
        }
    }
}
__device__ __forceinline__ void diff_combine(Frame& F, const bf16* O2, bf16* Oc, const float* lam_qk, const float* g_sub) {
    const int gw = F.vcu * NWAVES + F.wave, NGW = F.G * NWAVES;
    float s1 = lam_qk[F.lane] * lam_qk[128 + F.lane] + lam_qk[64 + F.lane] * lam_qk[192 + F.lane];
    float s2 = lam_qk[256 + F.lane] * lam_qk[384 + F.lane] + lam_qk[320 + F.lane] * lam_qk[448 + F.lane];
    s1 = wave_sum(s1, F.lane); s2 = wave_sum(s2, F.lane);
    const float lam = expf(s1) - expf(s2) + LAMBDA_INIT;
    const int e0 = (F.lane & 31) * 8;
    float gs[8];
#pragma unroll
    for (int e = 0; e < 8; ++e) gs[e] = g_sub[e0 + e] * (1.0f - LAMBDA_INIT);
    const int total = M * 8;
    constexpr int U = 4;
    for (int base = gw; base < total; base += NGW * U) {
        v4u a[U], b[U];
#pragma unroll
        for (int u = 0; u < U; ++u) { int it = base + NGW * u; if (it >= total) it = total - 1; const int m = it >> 3, h = (it & 7) * 2 + (F.lane >> 5);
            const GAS v4u* p1 = (const GAS v4u*)(O2 + (size_t)m * 8192 + (2 * h) * 256 + e0); a[u] = p1[0]; b[u] = p1[32]; }
#pragma unroll
        for (int u = 0; u < U; ++u) { const int it = base + NGW * u; const int m = it >> 3, h = (it & 7) * 2 + (F.lane >> 5);
            float x[8], y[8];
            x[0] = __uint_as_float(a[u].x << 16); x[1] = __uint_as_float(a[u].x & 0xffff0000u); x[2] = __uint_as_float(a[u].y << 16); x[3] = __uint_as_float(a[u].y & 0xffff0000u);
            x[4] = __uint_as_float(a[u].z << 16); x[5] = __uint_as_float(a[u].z & 0xffff0000u); x[6] = __uint_as_float(a[u].w << 16); x[7] = __uint_as_float(a[u].w & 0xffff0000u);
            y[0] = __uint_as_float(b[u].x << 16); y[1] = __uint_as_float(b[u].x & 0xffff0000u); y[2] = __uint_as_float(b[u].y << 16); y[3] = __uint_as_float(b[u].y & 0xffff0000u);
            y[4] = __uint_as_float(b[u].z << 16); y[5] = __uint_as_float(b[u].z & 0xffff0000u); y[6] = __uint_as_float(b[u].w << 16); y[7] = __uint_as_float(b[u].w & 0xffff0000u);
            float s = 0.f;
#pragma unroll
            for (int e = 0; e < 8; ++e) { x[e] = x[e] - lam * y[e]; s += x[e] * x[e]; }
            s += shflx(s, 1, F.lane); s += shflx(s, 2, F.lane); s += shflx(s, 4, F.lane); s += shflx(s, 8, F.lane); s += shflx(s, 16, F.lane);
            const float rstd = 1.0f / sqrtf(s * (1.f / 256.f) + EPS);
#pragma unroll
            for (int e = 0; e < 8; ++e) x[e] = x[e] * rstd * gs[e];
            v4u o; o.x = pk2(x[0], x[1]); o.y = pk2(x[2], x[3]); o.z = pk2(x[4], x[5]); o.w = pk2(x[6], x[7]);
            if (it < total) *(GAS v4u*)(Oc + (size_t)m * DM + h * 256 + e0) = o;
        }
    }
}
__device__ __forceinline__ void fill_lut(Frame& F, const float* rel_bias, const float* gq, const float* gk) {
    LAS float* lut = (LAS float*)(F.lds + RING_OFF + att::LDS_LUT); LAS float* bnd = (LAS float*)(F.lds + RING_OFF + att::LDS_BND);
    float mq = fmaxf(fabsf(gq[F.lane]), fabsf(gq[64 + F.lane])), mk = fmaxf(fabsf(gk[F.lane]), fabsf(gk[64 + F.lane]));
#pragma unroll
    for (int o = 1; o < 64; o <<= 1) { mq = fmaxf(mq, shflx(mq, o, F.lane)); mk = fmaxf(mk, shflx(mk, o, F.lane)); }
    const float bqk = LOG2E * 11.313708498984761f * 1.01f * mq * mk;
    if (F.tid < 32) { float mb = -3.0e38f;
        for (int k = 0; k < 32; ++k) mb = fmaxf(mb, rel_bias[k * 32 + F.tid]);
        bnd[F.tid] = bqk + mb * LOG2E; }
    __syncthreads();
    for (int i = F.tid; i < 32 * 129; i += NWAVES * 64) { const int m = i / 129, d = i - m * 129; lut[m * att::LUTS + d] = d < 128 ? rel_bias[T5_BUCKET[d] * 32 + m] * LOG2E - bnd[m] : -__builtin_inff(); }
    __syncthreads();
}

typedef const __attribute__((address_space(4))) Args* ArgsP;
#define TIDP() do { int t_ = phase_tid(wave_s); asm volatile("" : "+v"(t_)); F.tid = t_; F.lane = t_ & 63; F.wave = __builtin_amdgcn_readfirstlane(t_ >> 6); } while (0)
#define ARGP() ArgsP ap = (ArgsP)__builtin_amdgcn_kernarg_segment_ptr(); asm volatile("" : "+s"(ap))
__device__ __forceinline__ void grid_bar() { ArgsP ap = (ArgsP)__builtin_amdgcn_kernarg_segment_ptr(); asm volatile("" : "+s"(ap));
    XcdBarrier b; b.bar = (unsigned*)(ap->ws + WS_CTL) + CW_BAR; b.x = xb_xcc_id(); b.st = (volatile LAS unsigned*)(MISC_OFF + 32); xcd_barrier(b); }

constexpr int I_QKV = (DM / 64) * (NQKV / 64), I_SQ = (DM / 64) * (DM / 64), I_GU = (DM / 64) * (DFF / 64), I_D = (DFF / 64) * (DM / 64), I_KV = (DM / 64) * (2048 / 64);
constexpr int NITEMS = I_QKV + I_SQ + 2 * I_GU + I_D + I_KV + I_SQ + I_SQ + 2 * I_GU + I_D;
#define P0_DECODE(it_, T) do { int r = (it_); const float* W; int K, N; bf16* WT; const float* g; int mode, roff = 0;     \
            if (r < I_QKV) { W = A_w_qkv; K = DM; N = NQKV; WT = A_Wqkv_t; g = A_g_attn; mode = 0; } \
            else if ((r -= I_QKV) < I_SQ) { W = A_w_o_a; K = DM; N = DM; WT = A_Woa_t; g = nullptr; mode = 0; } \
            else if ((r -= I_SQ) < I_GU) { W = A_w_gate; K = DM; N = DFF; WT = A_Wgu0_t; g = A_g_ffn; mode = 1; } \
            else if ((r -= I_GU) < I_GU) { W = A_w_up; K = DM; N = DFF; WT = A_Wgu0_t; g = A_g_ffn; mode = 2; } \
            else if ((r -= I_GU) < I_D) { W = A_w_down; K = DFF; N = DM; WT = A_Wd0_t; g = nullptr; mode = 0; } \
            else if ((r -= I_D) < I_KV) { W = A_w_kv; K = DM; N = 2048; WT = A_Wkvq_t; g = A_g_kvn; mode = 0; } \
            else if ((r -= I_KV) < I_SQ) { W = A_w_q_b; K = DM; N = DM; WT = A_Wkvq_t; g = A_g_attn + DM; mode = 0; roff = 2048; } \
            else if ((r -= I_SQ) < I_SQ) { W = A_w_o_b; K = DM; N = DM; WT = A_Wob_t; g = nullptr; mode = 0; } \
            else if ((r -= I_SQ) < I_GU) { W = A_w_gate + (size_t)DM * DFF; K = DM; N = DFF; WT = A_Wgu1_t; g = A_g_ffn + DM; mode = 1; } \
            else if ((r -= I_GU) < I_GU) { W = A_w_up + (size_t)DM * DFF; K = DM; N = DFF; WT = A_Wgu1_t; g = A_g_ffn + DM; mode = 2; } \
            else { r -= I_GU; W = A_w_down + (size_t)DFF * DM; K = DFF; N = DM; WT = A_Wd1_t; g = nullptr; mode = 0; } \
            const int nblk = N / 64, kb = r / nblk, nb = r - kb * nblk, n0 = nb * 64, k0 = kb * 64; \
            const int drow0 = mode == 0 ? roff + n0 : (n0 >> 7) * 256 + (n0 & 127) + (mode == 2 ? 128 : 0); \
            T.src = W + (size_t)(k0 + 2 * (F.lane >> 4)) * N + n0 + 4 * (F.lane & 15); T.dst = WT + (size_t)drow0 * K + k0; T.gain = g ? g + k0 : nullptr; T.N = N; T.K = K; } while (0)
#define P0_RUN(PRE_, first, count, gw_, NGW_) do { LAS unsigned* scr = (LAS unsigned*)(F.lds + RING_OFF + F.wave * 16384); TItem ta{}, tb{}; f32x4 va[16] = {}, vb[16] = {}; f32x2 ga[8] = {}, gb[8] = {}; const int cnt_ = (count), ngw_ = (NGW_); \
        int it = (gw_); \
        if (it < cnt_) { P0_DECODE((first) + it, ta); P0_LOAD(PRE_, ta, va, ga); } \
        while (it < cnt_) { \
            const int it2 = it + ngw_, it3 = it2 + ngw_; \
            if (it2 < cnt_) { P0_DECODE((first) + it2, tb); P0_LOAD(PRE_, tb, vb, gb); } \
            p0_process<PRE_>(ta, va, ga, scr, F.lane); \
            if (it2 >= cnt_) break; \
            if (it3 < cnt_) { P0_DECODE((first) + it3, ta); P0_LOAD(PRE_, ta, va, ga); } \
            p0_process<PRE_>(tb, vb, gb, scr, F.lane); \
            it = it3; \
        } } while (0)
__global__ void __launch_bounds__(NWAVES * 64, 2) fwd_kernel(Args args) {
    extern __shared__ __attribute__((aligned(16))) unsigned char lds[];
    Frame F;
    F.lds = (LAS unsigned char*)lds;
    F.MISC = (volatile LAS unsigned*)(F.lds + MISC_OFF);
    const int wave_s = __builtin_amdgcn_readfirstlane((int)threadIdx.x >> 6);
    F.tid = threadIdx.x; F.lane = F.tid & 63; F.wave = wave_s;
    F.G = gridDim.x; { const int bx = blockIdx.x; F.vcu = (F.G % 8 == 0) ? (bx % 8) * (F.G / 8) + bx / 8 : bx; }
    { ARGP(); F.ctl = (gu32*)(ap->ws + WS_CTL); }
#define A_x        (ap->in[0])
#define A_rel_bias (ap->in[1])
#define A_g_attn   (ap->in[2])
#define A_g_ffn    (ap->in[3])
#define A_w_qkv    (ap->in[4])
#define A_w_o_a    (ap->in[5])
#define A_g_q_a    (ap->in[6])
#define A_g_k_a    (ap->in[7])
#define A_lam_qk   (ap->in[8])
#define A_g_sub    (ap->in[9])
#define A_g_kvn    (ap->in[10])
#define A_w_kv     (ap->in[11])
#define A_g_k_sh   (ap->in[12])
#define A_w_q_b    (ap->in[13])
#define A_w_o_b    (ap->in[14])
#define A_g_q_b    (ap->in[15])
#define A_sinks    (ap->in[16])
#define A_w_gate   (ap->in[17])
#define A_w_up     (ap->in[18])
#define A_w_down   (ap->in[19])
#define A_out      (ap->out)
#define WSB(off) ((bf16*)(ap->ws + (off)))
#define A_Wqkv_t WSB(WS_WQKV)
#define A_Woa_t  WSB(WS_WOA)
#define A_Wgu0_t WSB(WS_WGU0)
#define A_Wd0_t  WSB(WS_WD0)
#define A_Wkvq_t WSB(WS_WKVQ)
#define A_Wob_t  WSB(WS_WOB)
#define A_Wgu1_t WSB(WS_WGU1)
#define A_Wd1_t  WSB(WS_WD1)
#define A_H  WSB(WS_H)
#define A_R1 WSB(WS_R1)
#define A_R2 WSB(WS_R2)
#define A_XB WSB(WS_XB)
#define A_SS(k) ((float*)(ap->ws + WS_SS + (size_t)(k) * M * 4))
    for (int u = F.tid; u < (LDS_BYTES - LDSCTL_OFF) / 4; u += NWAVES * 64) ((LAS unsigned*)(F.lds + LDSCTL_OFF))[u] = 0u;
    __syncthreads();
    (void)xcd_barrier_post((unsigned*)(F.ctl + CW_BAR), F.MISC + 8);
#define GRID_BAR() grid_bar()
#ifndef PH_MASK
#define PH_MASK 0x1ffff
#endif
#ifndef PROBE_TWICE
#define PROBE_TWICE 0
#endif
#ifndef PROBE_LAYER
#define PROBE_LAYER 0
#endif
#define PH(k) _Pragma("nounroll") for (int rep_ = 0; rep_ < (((((PROBE_TWICE) >> (k)) & 1) && layer == (PROBE_LAYER)) ? 2 : 1); ++rep_, ((((PROBE_TWICE) >> (k)) & 1) && rep_ == 1 ? (GRID_BAR(), 0) : 0)) if constexpr (((PH_MASK) >> (k)) & 1)

    int layer = 0;
    PH(0)
    {
        ARGP(); TIDP();
        P0_RUN(true, 0, (NCONV) ? I_QKV : NITEMS, F.vcu * NWAVES + F.wave, F.G * NWAVES);
        raw_rows(F, A_x, A_XB, A_SS(0));
    }
    GRID_BAR();
    for (layer = 0; layer < 2; ++layer) {
        const bool L0 = layer == 0;
        const int NP = L0 ? NQKV : NKVQ;
        PH(1)
        {
            ARGP();
            pg8::Gemm g{A_XB, L0 ? A_Wqkv_t : A_Wkvq_t, M, NP, DM, DM}; pg8::StaticOrder S; S.init(M, NP, F.G, (int)blockIdx.x);
            pg8::EpiProj E{A_R1, NQKV, L0 ? A_SS(0) : A_SS(2), 1.0f / DM, EPS, L0 ? A_g_q_a : A_g_k_sh, L0 ? A_g_k_a : A_g_q_b, 0, L0 ? 16 : 4, L0 ? 16 : 8, L0 ? 32 : 24, L0 ? QSCALE : 1.0f, L0 ? 1.0f : QSCALE, EPS,
                           (PG8_LAS float*)(F.lds + att::LDS_LUT)};
            pg8::gemm_phase<pg8::EpiProj, pg8::StaticOrder, true, true>(F.lds + RING_OFF, g, S, E, phase_tid(wave_s));
        }
        GRID_BAR();
        PH(3)
        {
            ARGP(); TIDP();
            if (L0) {
                const int GS = (F.G % 8 == 0) ? F.G / 8 : F.G, xg = F.vcu / GS, lc = F.vcu - xg * GS, NGRP = F.G / GS, HPG = 32 / NGRP, QN = HPG * 64;
                constexpr int NCV = NCONV;
                if (lc >= GS - NCV) { P0_RUN(false, I_QKV, NITEMS - I_QKV, (xg * NCV + lc - (GS - NCV)) * NWAVES + F.wave, NGRP * NCV * NWAVES); }
                __syncthreads();
                fill_lut(F, A_rel_bias, A_g_q_a, A_g_k_a);
                const float* lq = A_lam_qk;
                float s1 = lq[F.lane] * lq[128 + F.lane] + lq[64 + F.lane] * lq[192 + F.lane], s2 = lq[256 + F.lane] * lq[384 + F.lane] + lq[320 + F.lane] * lq[448 + F.lane];
                s1 = wave_sum(s1, F.lane); s2 = wave_sum(s2, F.lane);
                const float lam = expf(s1) - expf(s2) + LAMBDA_INIT;
                const att::Stg stg = att::make_stg<NQKV>(F.wave, F.lane);
                const att::rsrc_t rs = __builtin_amdgcn_make_buffer_rsrc((void*)A_R1, 0, (int)((size_t)M * NQKV * 2), 0x00020000);
                gu32* qctr = F.ctl + CW_QUEUE + 64 * xg;
                const bf16* Hb = A_H;
                auto ref = [=](int jj, att::Block2& r) { const int rk = jj / HPG, bh = xg * HPG + jj - rk * HPG, qb = 63 - rk, b = bh >> 4, hh = bh & 15;
                    const unsigned base = (unsigned)b * (SEQ * NQKV * 2u) + hh * 512u;
                    r.Q = base + (unsigned)qb * (128u * NQKV * 2u); r.K = base + 4096u * 2u; r.V = base + 8192u * 2u;
                    r.O = (bf16*)Hb + ((size_t)b * SEQ + (size_t)qb * 128) * DM + hh * 256; r.P0 = qb * 128; r.map0 = 2 * hh; r.rev = 0; };
                int j;
                if (F.tid == 0) F.MISC[16] = __hip_atomic_fetch_add(qctr, 1u, RLX_AGENT);
                __syncthreads(); j = __builtin_amdgcn_readfirstlane((int)F.MISC[16]); __syncthreads();
                if (j < QN) {
                    att::Block2 cur; ref(j, cur); att::Seam2 S;
                    att::attn2_prime<NQKV>(rs, cur, (char*)lds + RING_OFF, S, stg, F.tid);
                    for (;;) {
                        j = att::attn2_block<NQKV, DM>(rs, cur, (unsigned*)qctr, F.MISC + 16, QN, ref, (char*)lds + RING_OFF, S, stg, F.tid, lam, A_g_sub, 1.0f - LAMBDA_INIT, EPS);
                        if (j >= QN) break;
                        ref(j, cur);
                    }
                }
            } else {
                fill_lut(F, A_rel_bias, A_g_q_b, A_g_k_sh);
                constexpr int NITEM = 2048;
                const att::rsrc_t rs = __builtin_amdgcn_make_buffer_rsrc((void*)A_R1, 0, (int)((size_t)M * NQKV * 2), 0x00020000);
                const att::Stg stg = att::make_stg<NQKV>(F.wave, F.lane);
#define ATT_REF(r, L) do { const int bh = (L) >> 5, qb = (L) & 31, b = bh >> 5, h = bh & 31; const unsigned base = (unsigned)b * (SEQ * NQKV * 2u); \
                r.Q = base + (unsigned)qb * (256u * NQKV * 2u) + (2048u + h * 128u) * 2u; r.K = base + (unsigned)(h >> 2) * 256u; r.V = base + (1024u + (h >> 2) * 128u) * 2u; \
                r.O = A_R2 + ((size_t)b * SEQ + (size_t)qb * 256) * 8192 + h * 128; r.P0 = qb * 256; r.map = h; r.sink2 = A_sinks[h] * LOG2E; } while (0)
                int L = blockIdx.x; asm volatile("" : "+s"(L));
                if (L < NITEM) {
                    att::BlockRef cur; ATT_REF(cur, L); att::Seam S;
                    att::attn_prime<NQKV>(rs, cur, 128, (char*)lds + RING_OFF, S, stg, F.tid);
                    for (;;) {
                        const bool last = L + (int)gridDim.x >= NITEM; const int Ln = last ? L : L + (int)gridDim.x;
                        att::BlockRef nxt = cur; if (!last) ATT_REF(nxt, Ln);
                        att::attn_block<NQKV, 8192>(rs, cur, nxt, SEQ, 128, (char*)lds + RING_OFF, S, stg, F.tid);
                        if (last) break;
                        cur = nxt; L = Ln;
                    }
                }
#undef ATT_REF
            }
        }
        GRID_BAR();
        PH(5)
        {
            ARGP();
            pg8::Gemm g{L0 ? A_H : A_R2, L0 ? A_Woa_t : A_Wob_t, M, DM, DM, L0 ? DM : 8192};     pg8::StaticOrder S; S.init(M, DM, F.G, (int)blockIdx.x);
            pg8::EpiResF32 E{L0 ? A_x : (const float*)nullptr, A_XB, (float*)nullptr, DM, A_XB, L0 ? A_SS(1) : A_SS(3)};
            pg8::gemm_phase<pg8::EpiResF32, pg8::StaticOrder, true, true>(F.lds + RING_OFF, g, S, E, phase_tid(wave_s));
        }
        GRID_BAR();
        PH(7)
        {
            ARGP();
            pg8::Gemm g{A_XB, L0 ? A_Wgu0_t : A_Wgu1_t, M, NGU, DM, DM}; pg8::StaticOrder S; S.init(M, NGU, F.G, (int)blockIdx.x);
            pg8::EpiSwiGLU E{A_R1, DFF, L0 ? A_SS(1) : A_SS(3), 1.0f / DM, EPS};
            pg8::gemm_phase<pg8::EpiSwiGLU, pg8::StaticOrder, true, true>(F.lds + RING_OFF, g, S, E, phase_tid(wave_s));
        }
        GRID_BAR();
        PH(8)
        {
            ARGP();
            pg8::Gemm g{A_R1, L0 ? A_Wd0_t : A_Wd1_t, M, DM, DFF, DFF}; pg8::StaticOrder S; S.init(M, DM, F.G, (int)blockIdx.x, 4);
            pg8::EpiResF32 E{(const float*)nullptr, A_XB, L0 ? (float*)nullptr : A_out, DM, L0 ? A_XB : (bf16*)nullptr, A_SS(2)};
            pg8::gemm_phase<pg8::EpiResF32, pg8::StaticOrder, true, true>(F.lds + RING_OFF, g, S, E, phase_tid(wave_s));
        }
        if (L0) GRID_BAR();
    }
}

extern "C" void kernel_launch(void* const* d_in, const int* in_sizes, int n_in, void* d_out, int out_size, void* d_ws, size_t ws_size, hipStream_t stream) {
    static int grid = 0;
    if (grid == 0) {
        if (n_in != 20 || in_sizes[0] != M * DM || out_size != M * DM || ws_size < WS_END) { fprintf(stderr, "kernel_launch: shape/workspace mismatch: n_in %d in0 %d out %d ws %zu (need %zu)\n", n_in, n_in > 0 ? in_sizes[0] : -1, out_size, ws_size, (size_t)WS_END); grid = -1; return; }
        int dev = 0, cus = 0, per_cu = 0;
        if (hipGetDevice(&dev) != hipSuccess || hipDeviceGetAttribute(&cus, hipDeviceAttributeMultiprocessorCount, dev) != hipSuccess) { grid = -1; return; }
        if (hipFuncSetAttribute((const void*)fwd_kernel, hipFuncAttributeMaxDynamicSharedMemorySize, LDS_BYTES) != hipSuccess) { fprintf(stderr, "kernel_launch: hipFuncSetAttribute failed\n"); grid = -1; return; }
        if (hipOccupancyMaxActiveBlocksPerMultiprocessor(&per_cu, (const void*)fwd_kernel, NWAVES * 64, LDS_BYTES) != hipSuccess || per_cu < 1) { fprintf(stderr, "kernel_launch: occupancy query says %d blocks per CU\n", per_cu); grid = -1; (void)hipGetLastError(); return; }
        grid = cus;
    }
    if (grid < 0) return;
    if (hipMemsetAsync((char*)d_ws + WS_CTL, 0, CTL_ZERO_BYTES, stream) != hipSuccess) return;
    Args a{};
    for (int i = 0; i < 20; ++i) a.in[i] = (const float*)d_in[i];
    a.out = (float*)d_out; a.ws = (unsigned char*)d_ws;
    hipLaunchKernelGGL(fwd_kernel, dim3(grid), dim3(NWAVES * 64), LDS_BYTES, stream, a);
}
```

```cpp
#include <hip/hip_runtime.h>
#include <hip/hip_bf16.h>
#include <cstdio>
#include <cstdint>
#include <cmath>

__device__ __forceinline__ int phase_tid(int wave_s) { int lane; asm volatile("v_mbcnt_lo_u32_b32 %0, -1, 0\n\tv_mbcnt_hi_u32_b32 %0, -1, %0" : "=v"(lane)); return wave_s * 64 + lane; }

__device__ __forceinline__ float shflx(float v, int k, int lane) { return __builtin_bit_cast(float, __builtin_amdgcn_ds_bpermute((lane ^ k) << 2, __builtin_bit_cast(int, v))); }
template <int CTRL> __device__ __forceinline__ float dppx(float a) { return __builtin_bit_cast(float, __builtin_amdgcn_update_dpp(0, __builtin_bit_cast(int, a), CTRL, 0xf, 0xf, true)); }
__device__ __forceinline__ float swz16(float a) { return __builtin_bit_cast(float, __builtin_amdgcn_ds_swizzle(__builtin_bit_cast(int, a), 0x401F)); }
__device__ __forceinline__ float sum16(float a) { a += dppx<0xB1>(a); a += dppx<0x4E>(a); a += dppx<0x141>(a); a += dppx<0x140>(a); return a; }
namespace pg8 {
#define PG8_LAS __attribute__((address_space(3)))
typedef unsigned short bf16_t;
typedef short bf16x8 __attribute__((ext_vector_type(8)));
typedef float f32x4 __attribute__((ext_vector_type(4)));
typedef unsigned u32x4 __attribute__((ext_vector_type(4)));
constexpr int BM = 256, BK = 64, HALF = 128, HTB = HALF * BK * 2  , STAGE_BYTES = 8 * HTB, NXCD = 8, WGM = 8;

__host__ __device__ __forceinline__ int lds_byte(int r, int c) { const int st = (r >> 4) * 2 + (c >> 5), rr = r & 15, cc = c & 31, ob = rr * 64 + cc * 2; return st * 1024 + (ob ^ (((ob >> 9) & 1) << 5)); }
__host__ __device__ __forceinline__ void stage_rc(int b, int& R, int& C) { const int st = b / 1024, sb = b % 1024, swz = sb ^ (((sb >> 9) & 1) << 5); R = (st >> 1) * 16 + swz / 64; C = (st & 1) * 32 + (swz % 64) / 2; }
__host__ __device__ __forceinline__ int perm32(int rho) { const int n = rho >> 4, i = rho & 15; return 8 * (i >> 2) + 4 * n + (i & 3); }

struct Unit { int pm, pn; };
struct Gemm { const bf16_t* A; const bf16_t* Bt; int M, N, K, lda; };

struct StaticOrder {
    int nM, nN, nwg, G, c, wgm;
    __host__ __device__ void init(int M, int N, int G_, int c_, int wgm_ = WGM) { nM = M / BM; nN = N / BM; nwg = nM * nN; G = G_; c = c_; wgm = wgm_; }
    __host__ __device__ bool next(int i, Unit& u) const {
        const long L = (long)i * G + c; if (L >= nwg) return false;
        int wgid = (int)L; { const int q = nwg / NXCD, r = nwg % NXCD, xcd = wgid % NXCD, off = wgid / NXCD; wgid = (xcd < r ? xcd * (q + 1) : r * (q + 1) + (xcd - r) * q) + off; }
        const int nig = wgm * nN, gid = wgid / nig, fm = gid * wgm, gsz = (nM - fm) < wgm ? (nM - fm) : wgm;
        u.pm = fm + ((wgid % nig) % gsz); u.pn = (wgid % nig) / gsz; return true;
    }
    __device__ __forceinline__ void a_ready(const Unit&) const {}
    __device__ __forceinline__ void done(const Unit&) const {}
};

__device__ __forceinline__ unsigned cvt_pk_bf16(float lo, float hi) { unsigned r; asm volatile("v_cvt_pk_bf16_f32 %0, %1, %2" : "=v"(r) : "v"(lo), "v"(hi)); return r; }
typedef float f32x2 __attribute__((ext_vector_type(2)));
struct EpiStoreBf16 {
    static constexpr bool PERM = true, AFTER_DRAIN = false;
    bf16_t* O; int ldc; const float* ss; float inv_k, eps;
    struct State { float rs[2][4]; };
    __device__ __forceinline__ void prep(State& s, const Unit& u, int wr, int fr) const {
        const int row0 = u.pm * BM + wr * 64 + fr; float t[2][4];
#pragma unroll
        for (int ai = 0; ai < 2; ++ai)
#pragma unroll
            for (int m = 0; m < 4; ++m) t[ai][m] = __builtin_nontemporal_load(ss + row0 + ai * HALF + m * 16);
#pragma unroll
        for (int ai = 0; ai < 2; ++ai)
#pragma unroll
            for (int m = 0; m < 4; ++m) s.rs[ai][m] = __builtin_amdgcn_rsqf(t[ai][m] * inv_k + eps);
    }
    __device__ __forceinline__ void operator()(const f32x4 (&acc)[2][2][4][2], const Unit& u, int wr, int wc, int fr, int fq, const State& st) const {
        const int row0 = u.pm * BM + wr * 64 + fr, col0 = u.pn * BM + wc * 32 + 8 * fq;
#pragma unroll
        for (int ai = 0; ai < 2; ++ai)
#pragma unroll
            for (int m = 0; m < 4; ++m) { bf16_t* rowp = O + (size_t)(row0 + ai * HALF + m * 16) * ldc + col0; const float r = st.rs[ai][m];
#pragma unroll
                for (int bj = 0; bj < 2; ++bj) { const f32x4 v0 = acc[ai][bj][m][0] * r, v1 = acc[ai][bj][m][1] * r;
                    u32x4 w; w.x = cvt_pk_bf16(v0[0], v0[1]); w.y = cvt_pk_bf16(v0[2], v0[3]); w.z = cvt_pk_bf16(v1[0], v1[1]); w.w = cvt_pk_bf16(v1[2], v1[3]);
                    *(u32x4*)(rowp + bj * HALF) = w; } }
    }
};
struct EpiProj {
    static constexpr bool PERM = true, AFTER_DRAIN = false;
    bf16_t* O; int ldc; const float* ss; float inv_k, eps;
    const float* gA; const float* gB; int a0, a1, b0, b1; float sA, sB, heps;
    PG8_LAS float* xs;
    struct State { float rs[2][4]; };
    __device__ __forceinline__ void prep(State& s, const Unit& u, int wr, int fr) const {
        const int row0 = u.pm * BM + wr * 64 + fr; float t[2][4];
#pragma unroll
        for (int ai = 0; ai < 2; ++ai)
#pragma unroll
            for (int m = 0; m < 4; ++m) t[ai][m] = __builtin_nontemporal_load(ss + row0 + ai * HALF + m * 16);
#pragma unroll
        for (int ai = 0; ai < 2; ++ai)
#pragma unroll
            for (int m = 0; m < 4; ++m) s.rs[ai][m] = __builtin_amdgcn_rsqf(t[ai][m] * inv_k + eps);
    }
    __device__ __forceinline__ void operator()(const f32x4 (&acc)[2][2][4][2], const Unit& u, int wr, int wc, int fr, int fq, const State& st) const {
        const int row0 = u.pm * BM + wr * 64 + fr, col0 = u.pn * BM + wc * 32 + 8 * fq;
        const int mode = (u.pn >= a0 && u.pn < a1) ? 1 : ((u.pn >= b0 && u.pn < b1) ? 2 : 0);
        float hr[2][2][4];
        f32x4 gv[2] = {(f32x4){1.f, 1.f, 1.f, 1.f}, (f32x4){1.f, 1.f, 1.f, 1.f}};
        if (mode) {
            const int lane = fq * 16 + fr;
            float sv[2][4][2];
#pragma unroll
            for (int ai = 0; ai < 2; ++ai)
#pragma unroll
                for (int m = 0; m < 4; ++m)
#pragma unroll
                    for (int bj = 0; bj < 2; ++bj) { const f32x4 v0 = acc[ai][bj][m][0] * st.rs[ai][m], v1 = acc[ai][bj][m][1] * st.rs[ai][m];
                        sv[ai][m][bj] = (v0[0] * v0[0] + v0[1] * v0[1]) + (v0[2] * v0[2] + v0[3] * v0[3]) + (v1[0] * v1[0] + v1[1] * v1[1]) + (v1[2] * v1[2] + v1[3] * v1[3]); }
#pragma unroll
            for (int ai = 0; ai < 2; ++ai)
#pragma unroll
                for (int m = 0; m < 4; ++m)
#pragma unroll
                    for (int bj = 0; bj < 2; ++bj) sv[ai][m][bj] += swz16(sv[ai][m][bj]);
            float tv[2][4][2];
#pragma unroll
            for (int ai = 0; ai < 2; ++ai)
#pragma unroll
                for (int m = 0; m < 4; ++m)
#pragma unroll
                    for (int bj = 0; bj < 2; ++bj) tv[ai][m][bj] = shflx(sv[ai][m][bj], 32, lane);
            if (fq == 0) {
#pragma unroll
                for (int ai = 0; ai < 2; ++ai)
#pragma unroll
                    for (int m = 0; m < 4; ++m)
#pragma unroll
                        for (int bj = 0; bj < 2; ++bj) xs[((wr * 2 + bj) * 128 + ai * 64 + m * 16 + fr) * 4 + wc] = sv[ai][m][bj] + tv[ai][m][bj];
            }
            const float* g = mode == 1 ? gA : gB; const float sc = mode == 1 ? sA : sB;
            gv[0] = *(const f32x4*)(g + wc * 32 + 8 * fq) * sc; gv[1] = *(const f32x4*)(g + wc * 32 + 8 * fq + 4) * sc;
            asm volatile("s_waitcnt lgkmcnt(0)" ::: "memory"); __builtin_amdgcn_s_barrier(); asm volatile("" ::: "memory");
#pragma unroll
            for (int ai = 0; ai < 2; ++ai)
#pragma unroll
                for (int m = 0; m < 4; ++m)
#pragma unroll
                    for (int bj = 0; bj < 2; ++bj) { const f32x4 t = *(const PG8_LAS f32x4*)(xs + ((wr * 2 + bj) * 128 + ai * 64 + m * 16 + fr) * 4);
                        hr[ai][bj][m] = __builtin_amdgcn_rsqf(((t[0] + t[1]) + (t[2] + t[3])) * (1.0f / 128.0f) + heps) * st.rs[ai][m]; }
        } else {
#pragma unroll
            for (int ai = 0; ai < 2; ++ai)
#pragma unroll
                for (int m = 0; m < 4; ++m) { hr[ai][0][m] = st.rs[ai][m]; hr[ai][1][m] = st.rs[ai][m]; }
        }
#pragma unroll
        for (int ai = 0; ai < 2; ++ai)
#pragma unroll
            for (int m = 0; m < 4; ++m) { bf16_t* rowp = O + (size_t)(row0 + ai * HALF + m * 16) * ldc + col0;
#pragma unroll
                for (int bj = 0; bj < 2; ++bj) { const f32x4 v0 = acc[ai][bj][m][0] * hr[ai][bj][m] * gv[0], v1 = acc[ai][bj][m][1] * hr[ai][bj][m] * gv[1];
                    u32x4 w; w.x = cvt_pk_bf16(v0[0], v0[1]); w.y = cvt_pk_bf16(v0[2], v0[3]); w.z = cvt_pk_bf16(v1[0], v1[1]); w.w = cvt_pk_bf16(v1[2], v1[3]);
                    *(u32x4*)(rowp + bj * HALF) = w; } }
    }
};
struct EpiSwiGLU {
    static constexpr bool PERM = true, AFTER_DRAIN = false;
    bf16_t* O; int ldc; const float* ss; float inv_k, eps;
    struct State { float rs[2][4]; };
    __device__ __forceinline__ void prep(State& s, const Unit& u, int wr, int fr) const {
        const int row0 = u.pm * BM + wr * 64 + fr; float t[2][4];
#pragma unroll
        for (int ai = 0; ai < 2; ++ai)
#pragma unroll
            for (int m = 0; m < 4; ++m) t[ai][m] = __builtin_nontemporal_load(ss + row0 + ai * HALF + m * 16);
#pragma unroll
        for (int ai = 0; ai < 2; ++ai)
#pragma unroll
            for (int m = 0; m < 4; ++m) s.rs[ai][m] = __builtin_amdgcn_rsqf(t[ai][m] * inv_k + eps);
    }
    __device__ __forceinline__ void operator()(const f32x4 (&acc)[2][2][4][2], const Unit& u, int wr, int wc, int fr, int fq, const State& st) const {
        const int row0 = u.pm * BM + wr * 64 + fr, col0 = u.pn * HALF + wc * 32 + 8 * fq;
#pragma unroll
        for (int ai = 0; ai < 2; ++ai)
#pragma unroll
            for (int m = 0; m < 4; ++m) { bf16_t* rowp = O + (size_t)(row0 + ai * HALF + m * 16) * ldc + col0; const float rstd = st.rs[ai][m];
                float r[8];
#pragma unroll
                for (int n = 0; n < 2; ++n)
#pragma unroll
                    for (int e = 0; e < 4; ++e) { const float g = acc[ai][0][m][n][e] * rstd, up = acc[ai][1][m][n][e] * rstd;
                        const float s = __builtin_amdgcn_rcpf(1.0f + __builtin_amdgcn_exp2f(-1.4426950408889634f * g));
                        r[n * 4 + e] = g * s * up; }
                u32x4 w; w.x = cvt_pk_bf16(r[0], r[1]); w.y = cvt_pk_bf16(r[2], r[3]); w.z = cvt_pk_bf16(r[4], r[5]); w.w = cvt_pk_bf16(r[6], r[7]);
                *(u32x4*)rowp = w; }
    }
};
struct EpiResF32 {
    static constexpr bool PERM = true, AFTER_DRAIN = false;
    const float* res32; const bf16_t* res16; float* out32; int ldc; bf16_t* xb; float* ss;
    struct State {};
    __device__ __forceinline__ void prep(State&, const Unit&, int, int) const {}
    __device__ __forceinline__ void operator()(const f32x4 (&acc)[2][2][4][2], const Unit& u, int wr, int wc, int fr, int fq, const State&) const {
        const int row0 = u.pm * BM + wr * 64 + fr, col0 = u.pn * BM + wc * 32 + 8 * fq;
        float sacc[2][4];
#pragma unroll
        for (int ai = 0; ai < 2; ++ai)
#pragma unroll
            for (int m = 0; m < 4; ++m) { const int row = row0 + ai * HALF + m * 16; const size_t off = (size_t)row * ldc + col0;
                f32x4 rv[2][2];
                if (res32) {
#pragma unroll
                    for (int bj = 0; bj < 2; ++bj)
#pragma unroll
                        for (int n = 0; n < 2; ++n) rv[bj][n] = *(const f32x4*)(res32 + off + bj * HALF + n * 4);
                } else {
#pragma unroll
                    for (int bj = 0; bj < 2; ++bj) { const u32x4 w = *(const u32x4*)(res16 + off + bj * HALF);
                        rv[bj][0] = (f32x4){__uint_as_float(w.x << 16), __uint_as_float(w.x & 0xffff0000u), __uint_as_float(w.y << 16), __uint_as_float(w.y & 0xffff0000u)};
                        rv[bj][1] = (f32x4){__uint_as_float(w.z << 16), __uint_as_float(w.z & 0xffff0000u), __uint_as_float(w.w << 16), __uint_as_float(w.w & 0xffff0000u)}; }
                }
                float s = 0.f;
#pragma unroll
                for (int bj = 0; bj < 2; ++bj) { const f32x4 v0 = rv[bj][0] + acc[ai][bj][m][0], v1 = rv[bj][1] + acc[ai][bj][m][1];
                    if (out32) { *(f32x4*)(out32 + off + bj * HALF) = v0; *(f32x4*)(out32 + off + bj * HALF + 4) = v1; }
                    if (xb) { u32x4 w; w.x = cvt_pk_bf16(v0[0], v0[1]); w.y = cvt_pk_bf16(v0[2], v0[3]); w.z = cvt_pk_bf16(v1[0], v1[1]); w.w = cvt_pk_bf16(v1[2], v1[3]); *(u32x4*)(xb + off + bj * HALF) = w;
                        s += ((v0[0] * v0[0] + v0[1] * v0[1]) + (v0[2] * v0[2] + v0[3] * v0[3])) + ((v1[0] * v1[0] + v1[1] * v1[1]) + (v1[2] * v1[2] + v1[3] * v1[3])); } }
                sacc[ai][m] = s; }
        if (xb) {
#pragma unroll
            for (int ai = 0; ai < 2; ++ai)
#pragma unroll
                for (int m = 0; m < 4; ++m) sacc[ai][m] += swz16(sacc[ai][m]);
            float tacc[2][4];
#pragma unroll
            for (int ai = 0; ai < 2; ++ai)
#pragma unroll
                for (int m = 0; m < 4; ++m) tacc[ai][m] = shflx(sacc[ai][m], 32, fq * 16 + fr);
#pragma unroll
            for (int ai = 0; ai < 2; ++ai)
#pragma unroll
                for (int m = 0; m < 4; ++m) { if (fq == 0) unsafeAtomicAdd(ss + row0 + ai * HALF + m * 16, sacc[ai][m] + tacc[ai][m]); }
        }
    }
};
template <class Epi, class Sched, bool ALIGN_EPI = false, bool SP2 = false>
__device__ __forceinline__ void gemm_phase(PG8_LAS unsigned char* lds, const Gemm g, const Sched& S, const Epi& E, int tid) {
    asm volatile("" : "+v"(tid));
    const int wid = __builtin_amdgcn_readfirstlane(tid >> 6), lane = tid & 63, wr = wid >> 2, wc = wid & 3, fr = lane & 15, fq = lane >> 4;
    const int K = g.K, nt = K / BK;
    unsigned voffA[2], voffB[2];
#pragma unroll
    for (int i = 0; i < 2; ++i) { int R, C; stage_rc(tid * 16 + i * 8192, R, C); const int Rb = Epi::PERM ? ((R & ~31) + perm32(R & 31)) : R;
        voffA[i] = (unsigned)(R * g.lda + C) * 2u; voffB[i] = (unsigned)(Rb * K + C) * 2u; }
    const size_t kstep = (size_t)(BK * 2);
    const size_t hstep = (size_t)HALF * K * 2;
    const size_t hstepA = (size_t)HALF * g.lda * 2, tstepA = 2 * hstepA;
    const size_t tstep = 2 * hstep;
    const unsigned ldsw = (unsigned)wid * 1024u;
    const int aoff = lds_byte(wr * 64 + fr, fq * 8), boff = lds_byte(wc * 32 + fr, fq * 8);
#define PG8_SA(b, h) (((b) * 2 + (h)) * HTB)
#define PG8_SB(b, h) ((4 + (b) * 2 + (h)) * HTB)
#define PG8_STAGE(bufoff, gbase, voff) do { _Pragma("unroll") for (int _i = 0; _i < 2; ++_i) \
        __builtin_amdgcn_global_load_lds((const unsigned*)((const char*)(gbase) + (voff)[_i]), (PG8_LAS unsigned*)(lds + (bufoff) + ldsw + _i * 8192), 16, 0, 0); } while (0)
#define PG8_LDA(dst, b, h) do { _Pragma("unroll") for (int m = 0; m < 4; ++m) _Pragma("unroll") for (int k = 0; k < 2; ++k) dst[m][k] = *(const PG8_LAS bf16x8*)(lds + PG8_SA(b, h) + aoff + m * 2048 + k * 1024); } while (0)
#define PG8_LDB(dst, b, h) do { _Pragma("unroll") for (int n = 0; n < 2; ++n) _Pragma("unroll") for (int k = 0; k < 2; ++k) dst[n][k] = *(const PG8_LAS bf16x8*)(lds + PG8_SB(b, h) + boff + n * 2048 + k * 1024); } while (0)
#define PG8_MMA(ai, bj, At, Bt) do { __builtin_amdgcn_s_setprio(1); _Pragma("unroll") for (int m = 0; m < 4; ++m) _Pragma("unroll") for (int n = 0; n < 2; ++n) _Pragma("unroll") for (int k = 0; k < 2; ++k) \
        acc[ai][bj][m][n] = __builtin_amdgcn_mfma_f32_16x16x32_bf16(Bt[n][k], At[m][k], acc[ai][bj][m][n], 0, 0, 0); __builtin_amdgcn_s_setprio(0); } while (0)
#define PG8_WAIT_V(n) asm volatile("s_waitcnt vmcnt(" #n ")" ::: "memory")
#define PG8_WAIT_L(n) asm volatile("s_waitcnt lgkmcnt(" #n ")" ::: "memory")
#define PG8_BAR __builtin_amdgcn_s_barrier()
#define PG8_SCHED __builtin_amdgcn_sched_barrier(0)
    Unit cur, nxt; int ui = 0;
    if (!S.next(0, cur)) return;
    typename Epi::State est; int est_pm = -1;
    f32x4 acc[2][2][4][2];
#pragma unroll
    for (int a = 0; a < 2; ++a)
#pragma unroll
        for (int b = 0; b < 2; ++b)
#pragma unroll
            for (int m = 0; m < 4; ++m)
#pragma unroll
                for (int n = 0; n < 2; ++n) acc[a][b][m][n] = (f32x4){0.f, 0.f, 0.f, 0.f};
    bf16x8 At[4][2], B0[2][2], B1[2][2];
    const char* cA = (const char*)g.A + (size_t)cur.pm * tstepA; const char* cB = (const char*)g.Bt + (size_t)cur.pn * tstep;
    S.a_ready(cur);
    if constexpr (SP2) {
        PG8_STAGE(PG8_SB(0, 0), cB, voffB); PG8_STAGE(PG8_SB(0, 1), cB + hstep, voffB); PG8_STAGE(PG8_SA(0, 0), cA, voffA); PG8_STAGE(PG8_SA(0, 1), cA + hstepA, voffA);
        if (wr == 1) PG8_BAR;
        PG8_WAIT_V(2); PG8_BAR;
        PG8_STAGE(PG8_SB(1, 0), cB + kstep, voffB); PG8_STAGE(PG8_SA(1, 0), cA + kstep, voffA); PG8_STAGE(PG8_SB(1, 1), cB + hstep + kstep, voffB);
        PG8_WAIT_V(6); PG8_BAR;
    } else {
        PG8_STAGE(PG8_SB(0, 0), cB, voffB); PG8_STAGE(PG8_SA(0, 0), cA, voffA); PG8_STAGE(PG8_SB(0, 1), cB + hstep, voffB); PG8_STAGE(PG8_SA(0, 1), cA + hstepA, voffA);
        if (wr == 1) PG8_BAR;
        PG8_WAIT_V(4); PG8_BAR;
        PG8_STAGE(PG8_SB(1, 0), cB + kstep, voffB); PG8_STAGE(PG8_SA(1, 0), cA + kstep, voffA); PG8_STAGE(PG8_SB(1, 1), cB + hstep + kstep, voffB);
        PG8_WAIT_V(6); PG8_BAR;
    }
    for (;;) {
        const bool has_next = S.next(ui + 1, nxt);
        const char* nA = has_next ? (const char*)g.A + (size_t)nxt.pm * tstepA : cA; const char* nB = has_next ? (const char*)g.Bt + (size_t)nxt.pn * tstep : cB;
        for (int t = 0; t < nt; t += 2) {
            const bool last = (t == nt - 2);
            const char* a1 = cA + (size_t)(t + 1) * kstep;
            const char* a2 = last ? nA : cA + (size_t)(t + 2) * kstep; const char* b2 = last ? nB : cB + (size_t)(t + 2) * kstep;
            const char* a3 = a2 + kstep; const char* b3 = b2 + kstep;
            if (last && has_next) S.a_ready(nxt);
            if constexpr (SP2) {
            PG8_LDB(B0, 0, 0); PG8_LDB(B1, 0, 1); PG8_SCHED; PG8_LDA(At, 0, 0); PG8_STAGE(PG8_SA(1, 1), a1 + hstepA, voffA);
            PG8_WAIT_V(8); PG8_WAIT_L(0); PG8_BAR; PG8_MMA(0, 0, At, B0); PG8_MMA(0, 1, At, B1); PG8_BAR; PG8_SCHED;
            PG8_LDA(At, 0, 1); PG8_STAGE(PG8_SB(0, 0), b2, voffB); PG8_STAGE(PG8_SB(0, 1), b2 + hstep, voffB); PG8_STAGE(PG8_SA(0, 0), a2, voffA);
            PG8_WAIT_V(8); PG8_WAIT_L(0); PG8_BAR; PG8_MMA(1, 0, At, B0); PG8_MMA(1, 1, At, B1); PG8_BAR; PG8_SCHED;
            PG8_LDB(B0, 1, 0); PG8_LDB(B1, 1, 1); PG8_SCHED; PG8_LDA(At, 1, 0); PG8_STAGE(PG8_SA(0, 1), a2 + hstepA, voffA);
            PG8_WAIT_V(8); PG8_WAIT_L(0); PG8_BAR; PG8_MMA(0, 0, At, B0); PG8_MMA(0, 1, At, B1); PG8_BAR; PG8_SCHED;
            PG8_LDA(At, 1, 1); PG8_STAGE(PG8_SB(1, 0), b3, voffB); PG8_STAGE(PG8_SB(1, 1), b3 + hstep, voffB); PG8_STAGE(PG8_SA(1, 0), a3, voffA);
            PG8_WAIT_V(8); PG8_WAIT_L(0); PG8_BAR; PG8_MMA(1, 0, At, B0); PG8_MMA(1, 1, At, B1); PG8_BAR; PG8_SCHED;
            } else {
            PG8_LDB(B0, 0, 0); PG8_SCHED; PG8_LDA(At, 0, 0); PG8_STAGE(PG8_SA(1, 1), a1 + hstepA, voffA);
            PG8_WAIT_L(8); PG8_BAR; PG8_WAIT_L(0); PG8_MMA(0, 0, At, B0); PG8_BAR; PG8_SCHED;
            PG8_LDB(B1, 0, 1); PG8_STAGE(PG8_SB(0, 0), b2, voffB);
            PG8_BAR; PG8_WAIT_L(0); PG8_MMA(0, 1, At, B1); PG8_BAR;
            PG8_LDA(At, 0, 1); PG8_STAGE(PG8_SA(0, 0), a2, voffA);
            PG8_BAR; PG8_WAIT_L(0); PG8_MMA(1, 0, At, B0); PG8_BAR; PG8_SCHED;
            PG8_STAGE(PG8_SB(0, 1), b2 + hstep, voffB);
            PG8_WAIT_V(6); PG8_BAR; PG8_MMA(1, 1, At, B1); PG8_BAR;
            PG8_LDB(B0, 1, 0); PG8_SCHED; PG8_LDA(At, 1, 0); PG8_STAGE(PG8_SA(0, 1), a2 + hstepA, voffA);
            PG8_WAIT_L(8); PG8_BAR; PG8_WAIT_L(0); PG8_MMA(0, 0, At, B0); PG8_BAR; PG8_SCHED;
            PG8_LDB(B1, 1, 1); PG8_STAGE(PG8_SB(1, 0), b3, voffB);
            PG8_BAR; PG8_WAIT_L(0); PG8_MMA(0, 1, At, B1); PG8_BAR;
            PG8_LDA(At, 1, 1); PG8_STAGE(PG8_SA(1, 0), a3, voffA);
            PG8_BAR; PG8_WAIT_L(0); PG8_MMA(1, 0, At, B0); PG8_BAR; PG8_SCHED;
            PG8_STAGE(PG8_SB(1, 1), b3 + hstep, voffB);
            PG8_WAIT_V(6); PG8_BAR; PG8_MMA(1, 1, At, B1); PG8_BAR;
            }
        }
        if constexpr (ALIGN_EPI) { if (wr == 0) PG8_BAR; }
        if constexpr (!Epi::AFTER_DRAIN) { if (cur.pm != est_pm) { E.prep(est, cur, wr, fr); est_pm = cur.pm; } E(acc, cur, wr, wc, fr, fq, est); S.done(cur); }
        if (!has_next) break;
#pragma unroll
        for (int a = 0; a < 2; ++a)
#pragma unroll
            for (int b = 0; b < 2; ++b)
#pragma unroll
                for (int m = 0; m < 4; ++m)
#pragma unroll
                    for (int n = 0; n < 2; ++n) acc[a][b][m][n] = (f32x4){0.f, 0.f, 0.f, 0.f};
        cur = nxt; cA = nA; cB = nB; ++ui;
        if constexpr (ALIGN_EPI) { if (wr == 1) PG8_BAR; }
    }
    PG8_WAIT_V(0);
    if constexpr (!ALIGN_EPI) { if (wr == 0) PG8_BAR; }
    PG8_BAR;
    if constexpr (Epi::AFTER_DRAIN) { E.fused(acc, cur, wr, wc, fr, fq, lds, wid, lane); S.done(cur); }
    (void)est_pm;
#undef PG8_SA
#undef PG8_SB
#undef PG8_STAGE
#undef PG8_LDA
#undef PG8_LDB
#undef PG8_MMA
#undef PG8_WAIT_V
#undef PG8_WAIT_L
#undef PG8_BAR
#undef PG8_SCHED
}
}
namespace att {
typedef unsigned short bf16;
typedef short bf16x8 __attribute__((ext_vector_type(8)));
typedef short s16x4 __attribute__((ext_vector_type(4)));
typedef float f32x16 __attribute__((ext_vector_type(16)));
typedef float f32x4 __attribute__((ext_vector_type(4)));
typedef unsigned u32x4 __attribute__((ext_vector_type(4)));
constexpr int D = 128, NW = 8, QBLK = 32, KVBLK = 64, QB = NW * QBLK;
constexpr int SHM_V = KVBLK * D * 2, SHM_K = KVBLK * D * 2;
constexpr int LDS_WS = 131072 + 512, LUTS = 160, LDS_LUT = LDS_WS + NW * 64 * 4, LDS_BND = LDS_LUT + 32 * LUTS * 4, LDS_BYTES = LDS_BND + 32 * 4;
#define KSWZ(row, colB) ((row) * 256 + ((colB) ^ (((row) & 7) << 4)))
#define SBAR() __builtin_amdgcn_sched_barrier(0)
__device__ __forceinline__ int v_st(int k, int c) { const int kk = (k & ~0xC) | ((k & 4) << 1) | ((k & 8) >> 1); return ((kk >> 3) * 4 + (c >> 5)) * 512 + ((kk & 7) * 32 + (c & 31)) * 2; }
__device__ __forceinline__ int v_rd_base(int lane) { return ((lane & 3) << 3) | (((lane >> 2) & 3) << 6) | (((lane >> 4) & 1) << 5) | (((lane >> 5) & 1) << 8); }
constexpr int v_rd_off(int d0, int ks, int half) { return d0 * 512 + ks * 4096 + half * 2048; }
__device__ __forceinline__ int crow(int r, int hi) { return (r & 3) + 8 * (r >> 2) + 4 * hi; }
__device__ __forceinline__ unsigned cvtpk(float lo, float hi) { unsigned r; asm volatile("v_cvt_pk_bf16_f32 %0, %1, %2" : "=v"(r) : "v"(lo), "v"(hi)); return r; }
__device__ __forceinline__ bf16x8 load8(const bf16* p) { return *reinterpret_cast<const bf16x8*>(p); }
__device__ __forceinline__ void bias_mask_tile(f32x16& p0, f32x16& p1, int dq, unsigned W, const float* lut) {
#pragma unroll
    for (int r = 0; r < 16; ++r) {
        const int c = (r & 3) + 8 * (r >> 2);
        const int d0 = dq - c, d1 = dq - c - 32;
        const int i0 = ((unsigned)d0 >= W) ? 128 : (d0 > 127 ? 127 : d0), i1 = ((unsigned)d1 >= W) ? 128 : (d1 > 127 ? 127 : d1);
        p0[r] += lut[i0]; p1[r] += lut[i1];
    }
}
__device__ __forceinline__ void partialSM(f32x16& p0) {
#pragma unroll
    for (int r = 0; r < 16; ++r) p0[r] = __builtin_amdgcn_exp2f(p0[r]);
}
__device__ __forceinline__ void finishSM(f32x16& p0, f32x16& p1, float& l_reg, bf16x8& pa0, bf16x8& pa1, bf16x8& pa2, bf16x8& pa3) {
#pragma unroll
    for (int r = 0; r < 16; ++r) p1[r] = __builtin_amdgcn_exp2f(p1[r]);
    float ps = 0;
#pragma unroll
    for (int r = 0; r < 16; ++r) ps += p0[r];
#pragma unroll
    for (int r = 0; r < 16; ++r) ps += p1[r];
    { auto rr = __builtin_amdgcn_permlane32_swap(__float_as_uint(ps), __float_as_uint(ps), false, false);
      ps = __uint_as_float(rr[0]) + __uint_as_float(rr[1]); }
    l_reg += ps;
#define PK4(P, B_, OUT) do { unsigned a0 = cvtpk(P[B_+0], P[B_+1]), a1 = cvtpk(P[B_+2], P[B_+3]);                          \
        unsigned b0 = cvtpk(P[B_+4], P[B_+5]), b1 = cvtpk(P[B_+6], P[B_+7]);                                             \
        auto r0 = __builtin_amdgcn_permlane32_swap(a0, b0, false, false); auto r1 = __builtin_amdgcn_permlane32_swap(a1, b1, false, false); \
        u32x4 w = {r0[0], r1[0], r0[1], r1[1]}; OUT = *reinterpret_cast<bf16x8*>(&w); } while (0)
    PK4(p0, 0, pa0); PK4(p0, 8, pa1); PK4(p1, 0, pa2); PK4(p1, 8, pa3);
#undef PK4
}
template <bool SK>
__device__ __forceinline__ void qkt(f32x16& p0, f32x16& p1, const char* K_lds, int r32, int hi, const bf16x8* qr, bool act, float binit) {
    if (SK && !act) { const float NEG = -__builtin_inff();
#pragma unroll
        for (int r = 0; r < 16; ++r) { p0[r] = NEG; p1[r] = NEG; } return; }
#pragma unroll
    for (int r = 0; r < 16; ++r) { p0[r] = binit; p1[r] = binit; }
    const char* kb[4];
#pragma unroll
    for (int dd = 0; dd < 4; ++dd) kb[dd] = K_lds + KSWZ(r32, (dd * 16 + hi * 8) * 2);
#pragma unroll
    for (int d0 = 0; d0 < 8; ++d0) { const char* a = kb[d0 & 3] + (d0 >> 2) * 128;
        bf16x8 b0 = *reinterpret_cast<const bf16x8*>(a);
        bf16x8 b1 = *reinterpret_cast<const bf16x8*>(a + 32 * 256);
        p0 = __builtin_amdgcn_mfma_f32_32x32x16_bf16(b0, qr[d0], p0, 0, 0, 0);
        p1 = __builtin_amdgcn_mfma_f32_32x32x16_bf16(b1, qr[d0], p1, 0, 0, 0); }
}
template <bool SK>
__device__ __forceinline__ void pv_tile(f32x16* o, int vb0, bf16x8 pa0, bf16x8 pa1, bf16x8 pa2, bf16x8 pa3, bool act) {
    if (SK && !act) return;
#define TRRD(dst, off) asm volatile("ds_read_b64_tr_b16 %0, %1 offset:%2" : "=&v"(dst) : "v"(vb0), "i"(off) : "memory")
#define PV_D0(d0) do { s16x4 l0, l1, l2, l3, h0, h1, h2, h3; constexpr int b_ = v_rd_off(d0, 0, 0); \
        TRRD(l0, b_); TRRD(h0, b_ + 2048); TRRD(l1, b_ + 4096); TRRD(h1, b_ + 6144); TRRD(l2, b_ + 8192); TRRD(h2, b_ + 10240); TRRD(l3, b_ + 12288); TRRD(h3, b_ + 14336); \
        asm volatile("s_waitcnt lgkmcnt(0)" ::: "memory"); SBAR();   \
        o[d0] = __builtin_amdgcn_mfma_f32_32x32x16_bf16(pa0, (bf16x8){l0[0], l0[1], l0[2], l0[3], h0[0], h0[1], h0[2], h0[3]}, o[d0], 0, 0, 0);   \
        o[d0] = __builtin_amdgcn_mfma_f32_32x32x16_bf16(pa1, (bf16x8){l1[0], l1[1], l1[2], l1[3], h1[0], h1[1], h1[2], h1[3]}, o[d0], 0, 0, 0);   \
        o[d0] = __builtin_amdgcn_mfma_f32_32x32x16_bf16(pa2, (bf16x8){l2[0], l2[1], l2[2], l2[3], h2[0], h2[1], h2[2], h2[3]}, o[d0], 0, 0, 0);   \
        o[d0] = __builtin_amdgcn_mfma_f32_32x32x16_bf16(pa3, (bf16x8){l3[0], l3[1], l3[2], l3[3], h3[0], h3[1], h3[2], h3[3]}, o[d0], 0, 0, 0); } while (0)
    PV_D0(0); PV_D0(1); PV_D0(2); PV_D0(3);
#undef PV_D0
#undef TRRD
}
__device__ __forceinline__ void pv256(f32x16* o, int vb0, bf16x8 pa0, bf16x8 pa1, bf16x8 pa2, bf16x8 pa3) {
#define TRRD(dst, off) asm volatile("ds_read_b64_tr_b16 %0, %1 offset:%2" : "=&v"(dst) : "v"(vb0), "i"(off) : "memory")
#define RD8(S, d) do { constexpr int b_ = ((d) >> 2) * 16384 + v_rd_off((d) & 3, 0, 0); \
        TRRD(S##l0, b_); TRRD(S##h0, b_ + 2048); TRRD(S##l1, b_ + 4096); TRRD(S##h1, b_ + 6144); TRRD(S##l2, b_ + 8192); TRRD(S##h2, b_ + 10240); TRRD(S##l3, b_ + 12288); TRRD(S##h3, b_ + 14336); } while (0)
#define MM4(S, d) do { \
        o[d] = __builtin_amdgcn_mfma_f32_32x32x16_bf16(pa0, (bf16x8){S##l0[0], S##l0[1], S##l0[2], S##l0[3], S##h0[0], S##h0[1], S##h0[2], S##h0[3]}, o[d], 0, 0, 0);   \
        o[d] = __builtin_amdgcn_mfma_f32_32x32x16_bf16(pa1, (bf16x8){S##l1[0], S##l1[1], S##l1[2], S##l1[3], S##h1[0], S##h1[1], S##h1[2], S##h1[3]}, o[d], 0, 0, 0);   \
        o[d] = __builtin_amdgcn_mfma_f32_32x32x16_bf16(pa2, (bf16x8){S##l2[0], S##l2[1], S##l2[2], S##l2[3], S##h2[0], S##h2[1], S##h2[2], S##h2[3]}, o[d], 0, 0, 0);   \
        o[d] = __builtin_amdgcn_mfma_f32_32x32x16_bf16(pa3, (bf16x8){S##l3[0], S##l3[1], S##l3[2], S##l3[3], S##h3[0], S##h3[1], S##h3[2], S##h3[3]}, o[d], 0, 0, 0); } while (0)
#define WAITL(n) do { asm volatile("s_waitcnt lgkmcnt(" #n ")" ::: "memory"); SBAR(); } while (0)
    s16x4 Al0, Al1, Al2, Al3, Ah0, Ah1, Ah2, Ah3, Bl0, Bl1, Bl2, Bl3, Bh0, Bh1, Bh2, Bh3;
    RD8(A, 0);
    RD8(B, 1); WAITL(8); MM4(A, 0);
    RD8(A, 2); WAITL(8); MM4(B, 1);
    RD8(B, 3); WAITL(8); MM4(A, 2);
    RD8(A, 4); WAITL(8); MM4(B, 3);
    RD8(B, 5); WAITL(8); MM4(A, 4);
    RD8(A, 6); WAITL(8); MM4(B, 5);
    RD8(B, 7); WAITL(8); MM4(A, 6);
    WAITL(0); MM4(B, 7);
#undef TRRD
#undef RD8
#undef MM4
#undef WAITL
}
typedef __amdgpu_buffer_rsrc_t rsrc_t;
#define LASV __attribute__((address_space(3))) void
__device__ __forceinline__ bf16x8 bload8(rsrc_t rs, unsigned voff, unsigned soff) { return __builtin_bit_cast(bf16x8, __builtin_amdgcn_raw_buffer_load_b128(rs, voff, soff, 0)); }
struct BlockRef { unsigned Q, K, V; bf16* O; int P0; int map; float sink2; };
struct Seam { bf16x8 qr[8]; int slot; };
struct Stg { unsigned k0, k1, v0, v1; };
__device__ __forceinline__ int swa_jlo(int P0, int W) { const int lowk = P0 - W + 1; return lowk > 0 ? lowk / KVBLK : 0; }
#define LASU __attribute__((address_space(3))) unsigned
#define VMW() asm volatile("s_waitcnt vmcnt(0)" ::: "memory")
#define VMWN(n) asm volatile("s_waitcnt vmcnt(%0)" :: "i"(n) : "memory")
template <int LDQK>
__device__ __forceinline__ Stg make_stg(int wid, int lane) {
    Stg g;
    { const int s = wid * 2, row = s * 4 + (lane >> 4), cc = lane & 15; g.k0 = (unsigned)(row * LDQK + ((cc ^ (row & 7)) * 8)) * 2u; }
    { const int s = wid * 2 + 1, row = s * 4 + (lane >> 4), cc = lane & 15; g.k1 = (unsigned)(row * LDQK + ((cc ^ (row & 7)) * 8)) * 2u; }
    { const int s = wid * 2, kk = (s >> 1) * 8 + ((lane >> 2) & 7), c = ((s & 1) * 2 + (lane >> 5)) * 32 + (lane & 3) * 8, k = (kk & ~0xC) | ((kk & 4) << 1) | ((kk & 8) >> 1); g.v0 = (unsigned)(k * LDQK + c) * 2u; }
    { const int s = wid * 2 + 1, kk = (s >> 1) * 8 + ((lane >> 2) & 7), c = ((s & 1) * 2 + (lane >> 5)) * 32 + (lane & 3) * 8, k = (kk & ~0xC) | ((kk & 4) << 1) | ((kk & 8) >> 1); g.v1 = (unsigned)(k * LDQK + c) * 2u; }
    return g;
}
template <int LDQK>
__device__ __forceinline__ void dma_tile(rsrc_t rs, unsigned Kh, unsigned Vh, int kbase, int slot, char* lds, int wid, const Stg& g) {
    const unsigned ko = Kh + (unsigned)kbase * (LDQK * 2u), vo = Vh + (unsigned)kbase * (LDQK * 2u);
    char* kd = lds + 3 * SHM_V + slot * SHM_K + wid * 2048; char* vd = lds + slot * SHM_V + wid * 2048;
    __builtin_amdgcn_raw_ptr_buffer_load_lds(rs, (LASV*)kd, 16, g.k0, ko, 0, 0);
    __builtin_amdgcn_raw_ptr_buffer_load_lds(rs, (LASV*)(kd + 1024), 16, g.k1, ko, 0, 0);
    __builtin_amdgcn_raw_ptr_buffer_load_lds(rs, (LASV*)vd, 16, g.v0, vo, 0, 0);
    __builtin_amdgcn_raw_ptr_buffer_load_lds(rs, (LASV*)(vd + 1024), 16, g.v1, vo, 0, 0);
}
template <int LDQK>
__device__ __forceinline__ void attn_prime(rsrc_t rs, const BlockRef& cur, int W, char* lds, Seam& S, const Stg& g, int tid) {
    const int wid = __builtin_amdgcn_readfirstlane(tid >> 6), lane = tid & 63, r32 = lane & 31, hi = lane >> 5;
    S.slot = 0;
    dma_tile<LDQK>(rs, cur.K, cur.V, swa_jlo(cur.P0, W) * KVBLK, 0, lds, wid, g);
#pragma unroll
    for (int d0 = 0; d0 < 8; ++d0) S.qr[d0] = bload8(rs, (unsigned)((wid * QBLK + r32) * LDQK + hi * 8) * 2u + d0 * 32, cur.Q);
    VMW(); __syncthreads();
}
template <int LDQK, int LDO>
__device__ __forceinline__ void attn_block(rsrc_t rs, const BlockRef& cur, const BlockRef& nxt, int skv, int W, char* lds, Seam& S, const Stg& g, int tid) {
    constexpr bool SK = true;
    const int wid = __builtin_amdgcn_readfirstlane(tid >> 6), lane = tid & 63, r32 = lane & 31, hi = lane >> 5;
    const int j_lo = swa_jlo(cur.P0, W);
    int j_hi = (cur.P0 + QB - 1) / KVBLK + 1; if (j_hi > skv / KVBLK) j_hi = skv / KVBLK;
    const int NT = j_hi - j_lo;
    const int kbn = swa_jlo(nxt.P0, W) * KVBLK;
    const int qlo = cur.P0 + wid * QBLK, qm = qlo + r32 - 4 * hi;
    char* V_lds = lds; char* K_lds = lds + 3 * SHM_V;
    float* ws = (float*)(lds + LDS_WS) + wid * 64; float* li_l = ws; const float* bnd = (const float*)(lds + LDS_BND);
    const float* lut = (const float*)(lds + LDS_LUT) + cur.map * LUTS;
    const float cfar = __builtin_bit_cast(float, __builtin_amdgcn_readfirstlane(__builtin_bit_cast(int, lut[127])));
    float l_reg = 0; f32x16 o[4] = {};
    const int vb0 = (int)(uintptr_t)V_lds + v_rd_base(lane);
    const unsigned Kh = cur.K, Vh = cur.V;
    int sl = S.slot;
#define NEXT(s) ((s) == 2 ? 0 : (s) + 1)
#define PREV(s) ((s) == 0 ? 2 : (s) - 1)
#define KBASE(t) ((j_lo + (t)) * KVBLK)
#define ACT(t) (KBASE(t) <= qlo + QBLK - 1 && KBASE(t) + KVBLK - 1 >= qlo - W + 1)
#define FIX(t) (KBASE(t) + KVBLK + 126 > qlo || KBASE(t) <= qlo + QBLK - 1 - W)
#define BINIT(t) (FIX(t) ? 0.f : cfar)
#define MASKT(P0_, P1_, t) do { const int kb_ = KBASE(t); if ((!SK || ACT(t)) && FIX(t)) bias_mask_tile(P0_, P1_, qm - kb_, (unsigned)W, lut); } while (0)
    f32x16 pA0, pA1, pB0, pB1; bf16x8 pa0, pa1, pa2, pa3;
    if (NT > 1) dma_tile<LDQK>(rs, Kh, Vh, KBASE(1), NEXT(sl), lds, wid, g);
    SBAR(); qkt<SK>(pA0, pA1, K_lds + sl * SHM_K, r32, hi, S.qr, ACT(0), BINIT(0));
    MASKT(pA0, pA1, 0); partialSM(pA0);
    VMW(); __syncthreads();
    sl = NEXT(sl);
#define HALF_STEP(PX0, PX1, PY0, PY1, t) do {                                                                  \
        if ((t) + 1 < NT) dma_tile<LDQK>(rs, Kh, Vh, KBASE((t) + 1), NEXT(sl), lds, wid, g);                                      \
        SBAR(); qkt<SK>(PX0, PX1, K_lds + sl * SHM_K, r32, hi, S.qr, ACT(t), BINIT(t));                                       \
        finishSM(PY0, PY1, l_reg, pa0, pa1, pa2, pa3); SBAR();                                                                \
        pv_tile<SK>(o, vb0 + PREV(sl) * SHM_V, pa0, pa1, pa2, pa3, ACT((t) - 1)); MASKT(PX0, PX1, (t)); partialSM(PX0); \
        VMW(); __syncthreads();                                                                                               \
        sl = NEXT(sl); } while (0)
    int t = 1;
    for (; t + 1 < NT; t += 2) {
        HALF_STEP(pB0, pB1, pA0, pA1, t);
        HALF_STEP(pA0, pA1, pB0, pB1, t + 1);
    }
    const bool even = (NT & 1) == 0;
    if (even) { SBAR(); qkt<SK>(pB0, pB1, K_lds + sl * SHM_K, r32, hi, S.qr, ACT(NT - 1), BINIT(NT - 1)); SBAR(); sl = NEXT(sl); }
    dma_tile<LDQK>(rs, nxt.K, nxt.V, kbn, sl, lds, wid, g); SBAR();
#pragma unroll
    for (int d0 = 0; d0 < 8; ++d0) S.qr[d0] = bload8(rs, (unsigned)((wid * QBLK + r32) * LDQK + hi * 8) * 2u + d0 * 32, nxt.Q);
    SBAR();
    S.slot = sl;
    finishSM(pA0, pA1, l_reg, pa0, pa1, pa2, pa3); SBAR();
    pv_tile<SK>(o, vb0 + (even ? PREV(PREV(sl)) : PREV(sl)) * SHM_V, pa0, pa1, pa2, pa3, ACT(even ? NT - 2 : NT - 1));
    if (even) { MASKT(pB0, pB1, NT - 1); partialSM(pB0);
        finishSM(pB0, pB1, l_reg, pa0, pa1, pa2, pa3); SBAR(); pv_tile<SK>(o, vb0 + PREV(sl) * SHM_V, pa0, pa1, pa2, pa3, ACT(NT - 1)); }
    SBAR(); VMWN(8); SBAR();
    if (hi == 0) li_l[r32] = l_reg + __builtin_amdgcn_exp2f(cur.sink2 - bnd[cur.map]);
    asm volatile("s_waitcnt lgkmcnt(0)" ::: "memory");
    float rli[16];
#pragma unroll
    for (int r = 0; r < 16; ++r) rli[r] = __builtin_amdgcn_rcpf(li_l[crow(r, hi)]);
    bf16* Ow = cur.O + (size_t)(wid * QBLK) * LDO;
#pragma unroll
    for (int r = 0; r < 16; ++r) { const int orow = crow(r, hi);
#pragma unroll
        for (int d0 = 0; d0 < 4; ++d0) { const float v = o[d0][r] * rli[r];
            const float vn = shflx(v, 1, lane);
            if ((r32 & 1) == 0) *(unsigned*)(Ow + (size_t)orow * LDO + d0 * 32 + r32) = cvtpk(v, vn); } }
    __syncthreads();
#undef KBASE
#undef ACT
#undef FIX
#undef BINIT
#undef MASKT
#undef HALF_STEP
#undef NEXT
#undef PREV
}
#undef VMW
#undef VMWN
#undef LASU

struct Block2 { unsigned Q, K, V; bf16* O; int P0; int map0; int rev; };
struct Seam2 { bf16x8 qr[8]; int st; };
constexpr int ST2 = 65536;
#define LASU __attribute__((address_space(3))) unsigned
#define VMW() asm volatile("s_waitcnt vmcnt(0)" ::: "memory")
#define VMWN(n) asm volatile("s_waitcnt vmcnt(%0)" :: "i"(n) : "memory")
template <int LD>
__device__ __forceinline__ void dma_k2(rsrc_t rs, unsigned Kb, int kbase, int st, char* lds, int wid, const Stg& g) {
    const unsigned so = Kb + (unsigned)kbase * (LD * 2u); char* d = lds + st * ST2 + wid * 2048;
    __builtin_amdgcn_raw_ptr_buffer_load_lds(rs, (LASV*)d, 16, g.k0, so, 0, 0);
    __builtin_amdgcn_raw_ptr_buffer_load_lds(rs, (LASV*)(d + 1024), 16, g.k1, so, 0, 0);
    __builtin_amdgcn_raw_ptr_buffer_load_lds(rs, (LASV*)(d + 16384), 16, g.k0, so + 256u, 0, 0);
    __builtin_amdgcn_raw_ptr_buffer_load_lds(rs, (LASV*)(d + 16384 + 1024), 16, g.k1, so + 256u, 0, 0);
}
template <int LD>
__device__ __forceinline__ void dma_v2(rsrc_t rs, unsigned Vb, int kbase, int st, char* lds, int wid, const Stg& g) {
    const unsigned so = Vb + (unsigned)kbase * (LD * 2u); char* d = lds + st * ST2 + wid * 2048;
    __builtin_amdgcn_raw_ptr_buffer_load_lds(rs, (LASV*)(d + 32768), 16, g.v0, so, 0, 0);
    __builtin_amdgcn_raw_ptr_buffer_load_lds(rs, (LASV*)(d + 32768 + 1024), 16, g.v1, so, 0, 0);
    __builtin_amdgcn_raw_ptr_buffer_load_lds(rs, (LASV*)(d + 49152), 16, g.v0, so + 256u, 0, 0);
    __builtin_amdgcn_raw_ptr_buffer_load_lds(rs, (LASV*)(d + 49152 + 1024), 16, g.v1, so + 256u, 0, 0);
}
template <int LD>
__device__ __forceinline__ void attn2_prime(rsrc_t rs, const Block2& cur, char* lds, Seam2& S, const Stg& g, int tid) {
    const int wid = __builtin_amdgcn_readfirstlane(tid >> 6), lane = tid & 63, r32 = lane & 31, hi = lane >> 5, ms = wid >> 2, rg = wid & 3;
    S.st = 0;
    const int ft = cur.rev ? (cur.P0 + 127) / KVBLK : 0;
    dma_k2<LD>(rs, cur.K, ft * KVBLK, 0, lds, wid, g); dma_v2<LD>(rs, cur.V, ft * KVBLK, 0, lds, wid, g);
    const unsigned ql = (unsigned)((rg * QBLK + r32) * LD + ms * 128 + hi * 8) * 2u;
#pragma unroll
    for (int d0 = 0; d0 < 8; ++d0) S.qr[d0] = bload8(rs, ql + d0 * 32, cur.Q);
    VMW(); __syncthreads();
}
template <int LD, int LDO, class RefFn>
__device__ __forceinline__ int attn2_block(rsrc_t rs, const Block2& cur, unsigned* qctr, volatile __attribute__((address_space(3))) unsigned* slot, int QN, RefFn ref, char* lds, Seam2& S, const Stg& g, int tid, float lam, const float* g_sub, float osc, float eps) {
    const int wid = __builtin_amdgcn_readfirstlane(tid >> 6), lane = tid & 63, ms = wid >> 2, rg = wid & 3;
    float l_reg = 0; f32x16 o[8] = {}; bf16x8 pa0, pa1, pa2, pa3;
    int st = S.st;
    Block2 nxt = cur; int jnx = QN;
    {
    const int r32 = lane & 31, hi = lane >> 5;
    const int NT = (cur.P0 + 127) / KVBLK + 1;
    const int tbase = cur.rev ? NT - 1 : 0, tstep = cur.rev ? -1 : 1; int nft = 0;
    const int qlo = cur.P0 + rg * QBLK, qm = qlo + r32 - 4 * hi;
    const float* lut = (const float*)(lds + LDS_LUT) + (cur.map0 + ms) * LUTS;
    const float cfar = __builtin_bit_cast(float, __builtin_amdgcn_readfirstlane(__builtin_bit_cast(int, lut[127])));
    const int s0 = st;
#define ISSUE_K(tt) do { if ((tt) < NT) dma_k2<LD>(rs, cur.K, (tbase + (tt) * tstep) * KVBLK, (s0 + (tt)) & 1, lds, wid, g); else dma_k2<LD>(rs, nxt.K, nft * KVBLK, (s0 + (tt)) & 1, lds, wid, g); } while (0)
#define ISSUE_V(tt) do { if ((tt) < NT) dma_v2<LD>(rs, cur.V, (tbase + (tt) * tstep) * KVBLK, (s0 + (tt)) & 1, lds, wid, g); else dma_v2<LD>(rs, nxt.V, nft * KVBLK, (s0 + (tt)) & 1, lds, wid, g); } while (0)
#define LOAD_NEXT_Q() do { SBAR(); const unsigned ql = (unsigned)((rg * QBLK + r32) * LD + ms * 128 + hi * 8) * 2u; _Pragma("unroll") for (int d0 = 0; d0 < 8; ++d0) S.qr[d0] = bload8(rs, ql + d0 * 32, nxt.Q); SBAR(); } while (0)
#define QKT_SM(t) do { const int sg = (s0 + (t)) & 1, kb = (tbase + (t) * tstep) * KVBLK; const bool fix = kb + KVBLK + 126 > qlo;     \
        int lx = lane; asm volatile("" : "+v"(lx)); const int r32x = lx & 31, hix = lx >> 5;     \
        f32x16 p0, p1; SBAR(); __builtin_amdgcn_s_setprio(2); qkt<false>(p0, p1, lds + sg * ST2 + ms * 16384, r32x, hix, S.qr, true, fix ? 0.f : cfar);     \
        if (fix) bias_mask_tile(p0, p1, qlo + r32x - 4 * hix - kb, 1u << 30, lut); \
        partialSM(p0); finishSM(p0, p1, l_reg, pa0, pa1, pa2, pa3); __builtin_amdgcn_s_setprio(0); SBAR(); } while (0)
#define PV(t) do { int lx = lane; asm volatile("" : "+v"(lx)); const int vb = (int)(uintptr_t)(lds + ((s0 + (t)) & 1) * ST2 + 32768) + v_rd_base(lx); SBAR(); \
        pv256(o, vb, pa0, pa1, pa2, pa3); SBAR(); } while (0)
#define HS_END(all) do { if (all) asm volatile("s_waitcnt vmcnt(0) lgkmcnt(0)" ::: "memory"); else asm volatile("s_waitcnt vmcnt(4) lgkmcnt(0)" ::: "memory"); \
        __builtin_amdgcn_s_barrier(); asm volatile("" ::: "memory"); } while (0)
#define FETCH_NEXT() do { jnx = __builtin_amdgcn_readfirstlane((int)*slot); if (jnx < QN) { ref(jnx, nxt); nft = nxt.rev ? (nxt.P0 + 127) / KVBLK : 0; } } while (0)
    if (ms == 0) {
#pragma nounroll
        for (int t = 0; t < NT; ++t) { const bool lastt = t + 1 == NT, claim = t + 2 == NT;
            if (lastt) FETCH_NEXT();
            ISSUE_K(t + 1); QKT_SM(t); HS_END(false);
            unsigned gq = 0;
            if (claim && tid == 0) gq = __hip_atomic_fetch_add(qctr, 1u, __ATOMIC_RELAXED, __HIP_MEMORY_SCOPE_AGENT);
            ISSUE_V(t + 1); PV(t);
            if (claim) { VMWN(4); if (tid == 0) *slot = gq; }
            HS_END(lastt); }
        HS_END(true);
    } else {
        ISSUE_K(1); HS_END(false);
#pragma nounroll
        for (int t = 0; t < NT; ++t) { const bool lastt = t + 1 == NT;
            ISSUE_V(t + 1); QKT_SM(t); HS_END(lastt);
            if (!lastt) { if (t + 2 == NT) FETCH_NEXT(); ISSUE_K(t + 2); }
            PV(t); HS_END(lastt); }
    }
#undef FETCH_NEXT
    LOAD_NEXT_Q();
#undef ISSUE_K
#undef ISSUE_V
#undef LOAD_NEXT_Q
#undef QKT_SM
#undef PV
#undef HS_END
    st = (s0 + NT) & 1;
    }
    S.st = st;
    int lane_e = lane; asm volatile("" : "+v"(lane_e));
    const int r32 = lane_e & 31, hi = lane_e >> 5;
    float* li_l = (float*)(lds + LDS_WS) + wid * 64;
    if (hi == 0) li_l[r32] = l_reg;
    asm volatile("s_waitcnt lgkmcnt(0)" ::: "memory");
    unsigned short* xr = (unsigned short*)(lds + (st ^ 1) * ST2 + rg * 16384);
    if (ms == 1) {
#pragma unroll
        for (int r = 0; r < 16; ++r) { const int row = crow(r, hi); const float f = __builtin_amdgcn_rcpf(li_l[row]) * lam;
#pragma unroll
            for (int d0 = 0; d0 < 8; ++d0) xr[row * 256 + d0 * 32 + r32] = (unsigned short)cvtpk(o[d0][r] * f, 0.f);
            if ((r & 3) == 3) asm volatile("" ::: "memory"); }
    }
    asm volatile("s_waitcnt lgkmcnt(0)" ::: "memory");
    __syncthreads();
    if (ms == 0) {
        float gs[8];
#pragma unroll
        for (int d0 = 0; d0 < 8; ++d0) gs[d0] = g_sub[d0 * 32 + r32] * osc;
        float rlv[16], av[16];
#pragma unroll
        for (int r = 0; r < 16; ++r) rlv[r] = __builtin_amdgcn_rcpf(li_l[crow(r, hi)]);
#pragma unroll
        for (int r = 0; r < 16; ++r) { const int row = crow(r, hi); float a = 0.f;
#pragma unroll
            for (int d0 = 0; d0 < 8; ++d0) { const float x2 = __uint_as_float((unsigned)xr[row * 256 + d0 * 32 + r32] << 16); const float v = o[d0][r] * rlv[r] - x2; a += v * v; }
            av[r] = sum16(a); }
#pragma unroll
        for (int r = 0; r < 16; ++r) av[r] += swz16(av[r]);
#pragma unroll
        for (int r = 0; r < 16; ++r) av[r] = __builtin_amdgcn_rsqf(av[r] * (1.f / 256.f) + eps);
#pragma unroll
        for (int r = 0; r < 16; ++r) { const int row = crow(r, hi);
#pragma unroll
            for (int d0 = 0; d0 < 8; ++d0) { const float x2 = __uint_as_float((unsigned)xr[row * 256 + d0 * 32 + r32] << 16);
                xr[row * 256 + d0 * 32 + r32] = (unsigned short)cvtpk((o[d0][r] * rlv[r] - x2) * av[r] * gs[d0], 0.f); }
            if ((r & 3) == 3) asm volatile("" ::: "memory"); }
        asm volatile("s_waitcnt lgkmcnt(0)" ::: "memory");
        bf16* Ow = cur.O + (size_t)(rg * QBLK) * LDO;
#pragma unroll
        for (int j = 0; j < 16; ++j) { const int c = lane_e + 64 * j, row = c >> 5, cc = c & 31;
            *(u32x4*)(Ow + (size_t)row * LDO + cc * 8) = *(const u32x4*)(xr + row * 256 + cc * 8); }
    }
    __syncthreads();
    return jnx;
}
#undef VMW
#undef VMWN
#undef LASU
#undef LASV
}
constexpr int NWAVES = 8;
constexpr int BATCH = 2, SEQ = 8192, DM = 4096, M = BATCH * SEQ;
constexpr int DFF = 11008, NQKV = 3 * DM, NGU = 2 * DFF, NKVQ = 2048 + DM;
constexpr float EPS = 1e-6f, LOG2E = 1.4426950408889634f, QSCALE = 0.08838834764831845f * LOG2E;
constexpr float LAMBDA_INIT = 0.2f;
__device__ const unsigned char T5_BUCKET[128] = {0, 1, 2, 3, 4, 5, 6, 7, 8, 9, 10, 11, 12, 13, 14, 15, 16, 16, 16, 17, 17, 18, 18, 18, 19, 19, 19, 20, 20, 20, 20, 21, 21, 21, 21, 22, 22, 22, 22, 22, 23, 23, 23, 23, 23, 23, 24, 24, 24, 24, 24, 24, 25, 25, 25, 25, 25, 25, 25, 26, 26, 26, 26, 26, 26, 26, 26, 27, 27, 27, 27, 27, 27, 27, 27, 27, 27, 28, 28, 28, 28, 28, 28, 28, 28, 28, 28, 29, 29, 29, 29, 29, 29, 29, 29, 29, 29, 29, 29, 30, 30, 30, 30, 30, 30, 30, 30, 30, 30, 30, 30, 30, 30, 31, 31, 31, 31, 31, 31, 31, 31, 31, 31, 31, 31, 31, 31, 31};
constexpr size_t MiB = 1u << 20;
constexpr size_t WS_CTL = 0, CTL_ZERO_BYTES = 1 * MiB;
constexpr size_t SZ_WQKV = (size_t)NQKV * DM * 2, SZ_WSQ = (size_t)DM * DM * 2, SZ_WGU = (size_t)NGU * DM * 2, SZ_WD = (size_t)DM * DFF * 2, SZ_WKVQ = (size_t)NKVQ * DM * 2;
constexpr size_t WS_WQKV = 1 * MiB, WS_WOA = WS_WQKV + SZ_WQKV, WS_WGU0 = WS_WOA + SZ_WSQ, WS_WD0 = WS_WGU0 + SZ_WGU, WS_WKVQ = WS_WD0 + SZ_WD, WS_WOB = WS_WKVQ + SZ_WKVQ,
                 WS_WGU1 = WS_WOB + SZ_WSQ, WS_WD1 = WS_WGU1 + SZ_WGU, WS_WEND = WS_WD1 + SZ_WD;
constexpr size_t WS_H = WS_WEND;
constexpr size_t WS_R1 = WS_H + (size_t)M * DM * 2;
constexpr size_t WS_R2 = WS_R1 + (size_t)M * NQKV * 2;
constexpr size_t WS_XB = WS_R2 + (size_t)M * 8192 * 2;
constexpr size_t WS_END = WS_XB + (size_t)M * DM * 2;
constexpr size_t WS_SS = 262144;
constexpr int CW_TMO = 0, CW_CODE = 1, CW_BAR = 4096, CW_QUEUE = 8192;
#ifndef NCONV
#define NCONV 4
#endif
constexpr int RING_OFF = 0, RING_BYTES = 131072;
constexpr int LDSCTL_OFF = RING_BYTES, MISC_OFF = LDSCTL_OFF + 320;
constexpr int LDS_BYTES = 154624;
static_assert(att::LDS_BYTES <= LDS_BYTES && MISC_OFF + 128 <= att::LDS_WS, "LDS map");
#define GAS __attribute__((address_space(1)))
#define LAS __attribute__((address_space(3)))
typedef unsigned short bf16;
typedef unsigned v4u __attribute__((ext_vector_type(4)));
typedef float f32x4 __attribute__((ext_vector_type(4)));
typedef short bf16x8 __attribute__((ext_vector_type(8)));
typedef GAS unsigned gu32;
typedef GAS unsigned long long gu64;
#define RLX_AGENT __ATOMIC_RELAXED, __HIP_MEMORY_SCOPE_AGENT
#define LDS_WAIT() asm volatile("s_waitcnt lgkmcnt(0)" ::: "memory")
#define VM_WAIT() asm volatile("s_waitcnt vmcnt(0)" ::: "memory")
__device__ __forceinline__ unsigned long long rt() { return __builtin_amdgcn_s_memrealtime(); }
__device__ __forceinline__ unsigned f2bf(float f) { unsigned u = __builtin_bit_cast(unsigned, f); return (u + 0x7fffu + ((u >> 16) & 1u)) >> 16; }
__device__ __forceinline__ unsigned pk2(float lo, float hi) { unsigned r; asm("v_cvt_pk_bf16_f32 %0, %1, %2" : "=v"(r) : "v"(lo), "v"(hi)); return r; }

#define XB_TMO      128
#define XB_XCNT(j)  (256  + 64 * (j))
#define XB_XSUB(j)  (1280 + 64 * (j))
#define XB_XGEN(j)  (2304 + 64 * (j))
#define XB_TOP      3328
#define XB_TOPGEN   3392
#define XCD_BAR_WORDS 3456
#define XB_SPIN_CAP (1u << 18)

__device__ __forceinline__ unsigned xb_ld(unsigned* p)              { return __hip_atomic_load(p, __ATOMIC_RELAXED, __HIP_MEMORY_SCOPE_AGENT); }
__device__ __forceinline__ unsigned xb_add(unsigned* p, unsigned v) { return __hip_atomic_fetch_add(p, v, __ATOMIC_RELAXED, __HIP_MEMORY_SCOPE_AGENT); }
__device__ __forceinline__ unsigned xb_xcc_id() { return (unsigned)__builtin_amdgcn_s_getreg((3 << 11) | 20) & 0xFu; }
#define XB_SPIN(cond, bar) do { unsigned _sp = 0; while (cond) { __builtin_amdgcn_s_sleep(1); \
    if ((++_sp & 255u) == 0u) { if (xb_ld(&(bar)[XB_TMO])) break; if (_sp > XB_SPIN_CAP) { atomicAdd(&(bar)[XB_TMO], 1u); break; } } } } while (0)

struct XcdBarrier {
    unsigned* bar; unsigned x;
    volatile LAS unsigned* st;
};

__device__ __forceinline__ XcdBarrier xcd_barrier_post(unsigned* bar, volatile LAS unsigned* st) {
    XcdBarrier b; b.bar = bar; b.x = xb_xcc_id(); b.st = st;
    if (threadIdx.x == 0) (void)xb_add(&bar[XB_XCNT(b.x)], 1u);
    return b;
}
__device__ __forceinline__ void xcd_barrier_complete(unsigned* bar, unsigned x, unsigned& nloc, unsigned& nx) {
    const unsigned G = gridDim.x * gridDim.y * gridDim.z;
    unsigned sum, cnt, mine, sp = 0u;
    for (;;) {
        sum = 0u; cnt = 0u; mine = 0u;
#pragma unroll
        for (unsigned j = 0; j < 16; ++j) { const unsigned c = xb_ld(&bar[XB_XCNT(j)]); sum += c; cnt += (c > 0u) ? 1u : 0u; }
        mine = xb_ld(&bar[XB_XCNT(x)]);
        if (sum == G) break;
        __builtin_amdgcn_s_sleep(1);
        if ((++sp & 255u) == 0u) { if (xb_ld(&bar[XB_TMO])) break; if (sp > XB_SPIN_CAP) { atomicAdd(&bar[XB_TMO], 1u); break; } }
    }
    nloc = mine > 0u ? mine : 1u; nx = cnt > 0u ? cnt : 1u;
}

__device__ __forceinline__ void xcd_barrier(const XcdBarrier& b) {
    asm volatile("s_waitcnt vmcnt(0)" ::: "memory");
    __syncthreads();
    if (threadIdx.x == 0) {
        unsigned* bar = b.bar; asm volatile("" : "+s"(bar));
        __builtin_amdgcn_s_waitcnt(0);
        unsigned nloc = b.st[0], nx = b.st[1];
        if (nloc == 0u) { xcd_barrier_complete(bar, b.x, nloc, nx); b.st[0] = nloc; b.st[1] = nx; }
        const unsigned old = xb_add(&bar[XB_XSUB(b.x)], 1u);
        const unsigned gen = old / nloc;
        if (old + 1u == (gen + 1u) * nloc) {
            __builtin_amdgcn_fence(__ATOMIC_RELEASE, "agent");
            asm volatile("s_waitcnt vmcnt(0)" ::: "memory");
            const unsigned og = xb_add(&bar[XB_TOP], 1u);
            const unsigned tg = og / nx;
            if (og + 1u == (tg + 1u) * nx) xb_add(&bar[XB_TOPGEN], 1u);
            else XB_SPIN(xb_ld(&bar[XB_TOPGEN]) == tg, bar);
            __builtin_amdgcn_fence(__ATOMIC_ACQUIRE, "agent");
            xb_add(&bar[XB_XGEN(b.x)], 1u);
            asm volatile("s_waitcnt vmcnt(0)" ::: "memory");
        } else {
            XB_SPIN(xb_ld(&bar[XB_XGEN(b.x)]) == gen, bar);
            __builtin_amdgcn_fence(__ATOMIC_ACQUIRE, "agent");
            asm volatile("s_waitcnt vmcnt(0)" ::: "memory");
        }
    }
    __syncthreads();
}
struct Args { const float* in[20]; float* out; unsigned char* ws; };
struct Frame {
    LAS unsigned char* lds; volatile LAS unsigned* MISC; gu32* ctl;
    int tid, lane, wave, vcu, G;
};
__device__ __forceinline__ float wave_sum(float v, int lane) { v = sum16(v); v += swz16(v); v += shflx(v, 32, lane); return v; }
struct TItem { const float* src; bf16* dst; const float* gain; int N, K; };
#define P0_LOAD(T, v) do { _Pragma("unroll") for (int i_ = 0; i_ < 16; ++i_) v[i_] = __builtin_nontemporal_load((const GAS f32x4*)(T.src + (size_t)(8 * (i_ >> 1) + (i_ & 1)) * T.N)); } while (0)
__device__ __forceinline__ void p0_process(const TItem& T, f32x4 (&v)[16], LAS unsigned* scr, int lane) {
    const int q = lane & 15, s = lane >> 4;
    if (T.gain) {
#pragma unroll
        for (int i = 0; i < 16; ++i) { const float g = T.gain[8 * (i >> 1) + 2 * s + (i & 1)]; v[i] = v[i] * g; }
    }
#pragma unroll
    for (int p = 0; p < 8; ++p)
#pragma unroll
        for (int e = 0; e < 4; ++e) scr[(4 * q + e) * 33 + 4 * p + s] = pk2(v[2 * p][e], v[2 * p + 1][e]);
    LDS_WAIT(); asm volatile("" ::: "memory");
    const int c = lane & 7;
#pragma unroll
    for (int j = 0; j < 8; ++j) { const int n = (lane >> 3) + 8 * j; const LAS unsigned* r = scr + n * 33 + 4 * c;
        v4u o; o.x = r[0]; o.y = r[1]; o.z = r[2]; o.w = r[3];
        __builtin_nontemporal_store(o, (GAS v4u*)(T.dst + (size_t)n * T.K + 8 * c)); }
    LDS_WAIT(); asm volatile("" ::: "memory");
}
__device__ __forceinline__ void raw_rows(Frame& F, const float* X, bf16* XB, float* ss) {
    const int gw = F.vcu * NWAVES + F.wave, NGW = F.G * NWAVES;
    for (int m = gw; m < M; m += NGW) {
        const GAS f32x4* xr = (const GAS f32x4*)(X + (size_t)m * DM) + F.lane;
        f32x4 v[16]; float s = 0.f;
#pragma unroll
        for (int j = 0; j < 16; ++j) { v[j] = xr[64 * j]; s += (v[j].x * v[j].x + v[j].y * v[j].y) + (v[j].z * v[j].z + v[j].w * v[j].w); }
        s = wave_sum(s, F.lane);
        if (F.lane == 0) ss[m] = s;
        GAS unsigned long long* o8 = (GAS unsigned long long*)(XB + (size_t)m * DM) + F.lane;
#pragma unroll
        for (int j = 0; j < 16; ++j) o8[64 * j] = (unsigned long long)pk2(v[j].x, v[j].y) | ((unsigned long long)pk2(v[j].z, v[j].w) << 32);
    }
}
__device__ __forceinline__ void head_norm(Frame& F, bf16* T, int ld, int nchunk, int nA, int colA, int colB, const float* gA, float sA, const float* gB, float sB) {
    const int gw = F.vcu * NWAVES + F.wave, NGW = F.G * NWAVES;
    const int d0 = (F.lane & 15) * 8;
    float ga[8], gb[8];
#pragma unroll
    for (int e = 0; e < 8; ++e) { ga[e] = gA[d0 + e] * sA; gb[e] = gB[d0 + e] * sB; }
    const int total = M * nchunk;
    constexpr int U = 8;
    for (int base = gw; base < total; base += NGW * U) {
        v4u w[U]; GAS v4u* p[U]; bool isA[U];
#pragma unroll
        for (int u = 0; u < U; ++u) { int it = base + NGW * u; if (it >= total) it = total - 1; const int m = it / nchunk, c = it - m * nchunk; isA[u] = c < nA;
            p[u] = (GAS v4u*)(T + (size_t)m * ld + (isA[u] ? colA + 512 * c : colB + 512 * (c - nA)) + F.lane * 8); w[u] = *p[u]; }
#pragma unroll
        for (int u = 0; u < U; ++u) {
            float x[8];
            x[0] = __uint_as_float(w[u].x << 16); x[1] = __uint_as_float(w[u].x & 0xffff0000u); x[2] = __uint_as_float(w[u].y << 16); x[3] = __uint_as_float(w[u].y & 0xffff0000u);
            x[4] = __uint_as_float(w[u].z << 16); x[5] = __uint_as_float(w[u].z & 0xffff0000u); x[6] = __uint_as_float(w[u].w << 16); x[7] = __uint_as_float(w[u].w & 0xffff0000u);
            float s = 0.f;
#pragma unroll
            for (int e = 0; e < 8; ++e) s += x[e] * x[e];
            s += shflx(s, 1, F.lane); s += shflx(s, 2, F.lane); s += shflx(s, 4, F.lane); s += shflx(s, 8, F.lane);
            const float rstd = 1.0f / sqrtf(s * (1.f / 128.f) + EPS);
#pragma unroll
            for (int e = 0; e < 8; ++e) x[e] = x[e] * rstd * (isA[u] ? ga[e] : gb[e]);
            v4u o; o.x = pk2(x[0], x[1]); o.y = pk2(x[2], x[3]); o.z = pk2(x[4], x[5]); o.w = pk2(x[6], x[7]);
            if (base + NGW * u < total) *p[u] = o;
        }
    }
}
__device__ __forceinline__ void diff_combine(Frame& F, const bf16* O2, bf16* Oc, const float* lam_qk, const float* g_sub) {
    const int gw = F.vcu * NWAVES + F.wave, NGW = F.G * NWAVES;
    float s1 = lam_qk[F.lane] * lam_qk[128 + F.lane] + lam_qk[64 + F.lane] * lam_qk[192 + F.lane];
    float s2 = lam_qk[256 + F.lane] * lam_qk[384 + F.lane] + lam_qk[320 + F.lane] * lam_qk[448 + F.lane];
    s1 = wave_sum(s1, F.lane); s2 = wave_sum(s2, F.lane);
    const float lam = expf(s1) - expf(s2) + LAMBDA_INIT;
    const int e0 = (F.lane & 31) * 8;
    float gs[8];
#pragma unroll
    for (int e = 0; e < 8; ++e) gs[e] = g_sub[e0 + e] * (1.0f - LAMBDA_INIT);
    const int total = M * 8;
    constexpr int U = 4;
    for (int base = gw; base < total; base += NGW * U) {
        v4u a[U], b[U];
#pragma unroll
        for (int u = 0; u < U; ++u) { int it = base + NGW * u; if (it >= total) it = total - 1; const int m = it >> 3, h = (it & 7) * 2 + (F.lane >> 5);
            const GAS v4u* p1 = (const GAS v4u*)(O2 + (size_t)m * 8192 + (2 * h) * 256 + e0); a[u] = p1[0]; b[u] = p1[32]; }
#pragma unroll
        for (int u = 0; u < U; ++u) { const int it = base + NGW * u; const int m = it >> 3, h = (it & 7) * 2 + (F.lane >> 5);
            float x[8], y[8];
            x[0] = __uint_as_float(a[u].x << 16); x[1] = __uint_as_float(a[u].x & 0xffff0000u); x[2] = __uint_as_float(a[u].y << 16); x[3] = __uint_as_float(a[u].y & 0xffff0000u);
            x[4] = __uint_as_float(a[u].z << 16); x[5] = __uint_as_float(a[u].z & 0xffff0000u); x[6] = __uint_as_float(a[u].w << 16); x[7] = __uint_as_float(a[u].w & 0xffff0000u);
            y[0] = __uint_as_float(b[u].x << 16); y[1] = __uint_as_float(b[u].x & 0xffff0000u); y[2] = __uint_as_float(b[u].y << 16); y[3] = __uint_as_float(b[u].y & 0xffff0000u);
            y[4] = __uint_as_float(b[u].z << 16); y[5] = __uint_as_float(b[u].z & 0xffff0000u); y[6] = __uint_as_float(b[u].w << 16); y[7] = __uint_as_float(b[u].w & 0xffff0000u);
            float s = 0.f;
#pragma unroll
            for (int e = 0; e < 8; ++e) { x[e] = x[e] - lam * y[e]; s += x[e] * x[e]; }
            s += shflx(s, 1, F.lane); s += shflx(s, 2, F.lane); s += shflx(s, 4, F.lane); s += shflx(s, 8, F.lane); s += shflx(s, 16, F.lane);
            const float rstd = 1.0f / sqrtf(s * (1.f / 256.f) + EPS);
#pragma unroll
            for (int e = 0; e < 8; ++e) x[e] = x[e] * rstd * gs[e];
            v4u o; o.x = pk2(x[0], x[1]); o.y = pk2(x[2], x[3]); o.z = pk2(x[4], x[5]); o.w = pk2(x[6], x[7]);
            if (it < total) *(GAS v4u*)(Oc + (size_t)m * DM + h * 256 + e0) = o;
        }
    }
}
__device__ __forceinline__ void fill_lut(Frame& F, const float* rel_bias, const float* gq, const float* gk) {
    LAS float* lut = (LAS float*)(F.lds + RING_OFF + att::LDS_LUT); LAS float* bnd = (LAS float*)(F.lds + RING_OFF + att::LDS_BND);
    float mq = fmaxf(fabsf(gq[F.lane]), fabsf(gq[64 + F.lane])), mk = fmaxf(fabsf(gk[F.lane]), fabsf(gk[64 + F.lane]));
#pragma unroll
    for (int o = 1; o < 64; o <<= 1) { mq = fmaxf(mq, shflx(mq, o, F.lane)); mk = fmaxf(mk, shflx(mk, o, F.lane)); }
    const float bqk = LOG2E * 11.313708498984761f * 1.01f * mq * mk;
    if (F.tid < 32) { float mb = -3.0e38f;
        for (int k = 0; k < 32; ++k) mb = fmaxf(mb, rel_bias[k * 32 + F.tid]);
        bnd[F.tid] = bqk + mb * LOG2E; }
    __syncthreads();
    for (int i = F.tid; i < 32 * 129; i += NWAVES * 64) { const int m = i / 129, d = i - m * 129; lut[m * att::LUTS + d] = d < 128 ? rel_bias[T5_BUCKET[d] * 32 + m] * LOG2E - bnd[m] : -__builtin_inff(); }
    __syncthreads();
}

typedef const __attribute__((address_space(4))) Args* ArgsP;
#define TIDP() do { int t_ = phase_tid(wave_s); asm volatile("" : "+v"(t_)); F.tid = t_; F.lane = t_ & 63; F.wave = __builtin_amdgcn_readfirstlane(t_ >> 6); } while (0)
#define ARGP() ArgsP ap = (ArgsP)__builtin_amdgcn_kernarg_segment_ptr(); asm volatile("" : "+s"(ap))
__device__ __forceinline__ void grid_bar() { ArgsP ap = (ArgsP)__builtin_amdgcn_kernarg_segment_ptr(); asm volatile("" : "+s"(ap));
    XcdBarrier b; b.bar = (unsigned*)(ap->ws + WS_CTL) + CW_BAR; b.x = xb_xcc_id(); b.st = (volatile LAS unsigned*)(MISC_OFF + 32); xcd_barrier(b); }

constexpr int I_QKV = (DM / 64) * (NQKV / 64), I_SQ = (DM / 64) * (DM / 64), I_GU = (DM / 64) * (DFF / 64), I_D = (DFF / 64) * (DM / 64), I_KV = (DM / 64) * (2048 / 64);
constexpr int NITEMS = I_QKV + I_SQ + 2 * I_GU + I_D + I_KV + I_SQ + I_SQ + 2 * I_GU + I_D;
#define P0_DECODE(it_, T) do { int r = (it_); const float* W; int K, N; bf16* WT; const float* g; int mode, roff = 0;     \
            if (r < I_QKV) { W = A_w_qkv; K = DM; N = NQKV; WT = A_Wqkv_t; g = A_g_attn; mode = 0; } \
            else if ((r -= I_QKV) < I_SQ) { W = A_w_o_a; K = DM; N = DM; WT = A_Woa_t; g = nullptr; mode = 0; } \
            else if ((r -= I_SQ) < I_GU) { W = A_w_gate; K = DM; N = DFF; WT = A_Wgu0_t; g = A_g_ffn; mode = 1; } \
            else if ((r -= I_GU) < I_GU) { W = A_w_up; K = DM; N = DFF; WT = A_Wgu0_t; g = A_g_ffn; mode = 2; } \
            else if ((r -= I_GU) < I_D) { W = A_w_down; K = DFF; N = DM; WT = A_Wd0_t; g = nullptr; mode = 0; } \
            else if ((r -= I_D) < I_KV) { W = A_w_kv; K = DM; N = 2048; WT = A_Wkvq_t; g = A_g_kvn; mode = 0; } \
            else if ((r -= I_KV) < I_SQ) { W = A_w_q_b; K = DM; N = DM; WT = A_Wkvq_t; g = A_g_attn + DM; mode = 0; roff = 2048; } \
            else if ((r -= I_SQ) < I_SQ) { W = A_w_o_b; K = DM; N = DM; WT = A_Wob_t; g = nullptr; mode = 0; } \
            else if ((r -= I_SQ) < I_GU) { W = A_w_gate + (size_t)DM * DFF; K = DM; N = DFF; WT = A_Wgu1_t; g = A_g_ffn + DM; mode = 1; } \
            else if ((r -= I_GU) < I_GU) { W = A_w_up + (size_t)DM * DFF; K = DM; N = DFF; WT = A_Wgu1_t; g = A_g_ffn + DM; mode = 2; } \
            else { r -= I_GU; W = A_w_down + (size_t)DFF * DM; K = DFF; N = DM; WT = A_Wd1_t; g = nullptr; mode = 0; } \
            const int nblk = N / 64, kb = r / nblk, nb = r - kb * nblk, n0 = nb * 64, k0 = kb * 64; \
            const int drow0 = mode == 0 ? roff + n0 : (n0 >> 7) * 256 + (n0 & 127) + (mode == 2 ? 128 : 0); \
            T.src = W + (size_t)(k0 + 2 * (F.lane >> 4)) * N + n0 + 4 * (F.lane & 15); T.dst = WT + (size_t)drow0 * K + k0; T.gain = g ? g + k0 : nullptr; T.N = N; T.K = K; } while (0)
#define P0_RUN(first, count, gw_, NGW_) do { LAS unsigned* scr = (LAS unsigned*)(F.lds + RING_OFF + F.wave * 16384); TItem ta{}, tb{}; f32x4 va[16] = {}, vb[16] = {}; const int cnt_ = (count), ngw_ = (NGW_); \
        int it = (gw_); \
        if (it < cnt_) { P0_DECODE((first) + it, ta); P0_LOAD(ta, va); } \
        while (it < cnt_) { \
            const int it2 = it + ngw_, it3 = it2 + ngw_; \
            if (it2 < cnt_) { P0_DECODE((first) + it2, tb); P0_LOAD(tb, vb); } \
            p0_process(ta, va, scr, F.lane); \
            if (it2 >= cnt_) break; \
            if (it3 < cnt_) { P0_DECODE((first) + it3, ta); P0_LOAD(ta, va); } \
            p0_process(tb, vb, scr, F.lane); \
            it = it3; \
        } } while (0)
__global__ void __launch_bounds__(NWAVES * 64, 2) fwd_kernel(Args args) {
    extern __shared__ __attribute__((aligned(16))) unsigned char lds[];
    Frame F;
    F.lds = (LAS unsigned char*)lds;
    F.MISC = (volatile LAS unsigned*)(F.lds + MISC_OFF);
    const int wave_s = __builtin_amdgcn_readfirstlane((int)threadIdx.x >> 6);
    F.tid = threadIdx.x; F.lane = F.tid & 63; F.wave = wave_s;
    F.G = gridDim.x; { const int bx = blockIdx.x; F.vcu = (F.G % 8 == 0) ? (bx % 8) * (F.G / 8) + bx / 8 : bx; }
    { ARGP(); F.ctl = (gu32*)(ap->ws + WS_CTL); }
#define A_x        (ap->in[0])
#define A_rel_bias (ap->in[1])
#define A_g_attn   (ap->in[2])
#define A_g_ffn    (ap->in[3])
#define A_w_qkv    (ap->in[4])
#define A_w_o_a    (ap->in[5])
#define A_g_q_a    (ap->in[6])
#define A_g_k_a    (ap->in[7])
#define A_lam_qk   (ap->in[8])
#define A_g_sub    (ap->in[9])
#define A_g_kvn    (ap->in[10])
#define A_w_kv     (ap->in[11])
#define A_g_k_sh   (ap->in[12])
#define A_w_q_b    (ap->in[13])
#define A_w_o_b    (ap->in[14])
#define A_g_q_b    (ap->in[15])
#define A_sinks    (ap->in[16])
#define A_w_gate   (ap->in[17])
#define A_w_up     (ap->in[18])
#define A_w_down   (ap->in[19])
#define A_out      (ap->out)
#define WSB(off) ((bf16*)(ap->ws + (off)))
#define A_Wqkv_t WSB(WS_WQKV)
#define A_Woa_t  WSB(WS_WOA)
#define A_Wgu0_t WSB(WS_WGU0)
#define A_Wd0_t  WSB(WS_WD0)
#define A_Wkvq_t WSB(WS_WKVQ)
#define A_Wob_t  WSB(WS_WOB)
#define A_Wgu1_t WSB(WS_WGU1)
#define A_Wd1_t  WSB(WS_WD1)
#define A_H  WSB(WS_H)
#define A_R1 WSB(WS_R1)
#define A_R2 WSB(WS_R2)
#define A_XB WSB(WS_XB)
#define A_SS(k) ((float*)(ap->ws + WS_SS + (size_t)(k) * M * 4))
    for (int u = F.tid; u < (LDS_BYTES - LDSCTL_OFF) / 4; u += NWAVES * 64) ((LAS unsigned*)(F.lds + LDSCTL_OFF))[u] = 0u;
    __syncthreads();
    (void)xcd_barrier_post((unsigned*)(F.ctl + CW_BAR), F.MISC + 8);
#define GRID_BAR() grid_bar()
#ifndef PH_MASK
#define PH_MASK 0x1ffff
#endif
#ifndef PROBE_TWICE
#define PROBE_TWICE 0
#endif
#ifndef PROBE_LAYER
#define PROBE_LAYER 0
#endif
#define PH(k) _Pragma("nounroll") for (int rep_ = 0; rep_ < (((((PROBE_TWICE) >> (k)) & 1) && layer == (PROBE_LAYER)) ? 2 : 1); ++rep_, ((((PROBE_TWICE) >> (k)) & 1) && rep_ == 1 ? (GRID_BAR(), 0) : 0)) if constexpr (((PH_MASK) >> (k)) & 1)

    int layer = 0;
    PH(0)
    {
        ARGP(); TIDP();
        P0_RUN(0, (NCONV) ? I_QKV : NITEMS, F.vcu * NWAVES + F.wave, F.G * NWAVES);
        raw_rows(F, A_x, A_XB, A_SS(0));
    }
    GRID_BAR();
    for (layer = 0; layer < 2; ++layer) {
        const bool L0 = layer == 0;
        const int NP = L0 ? NQKV : NKVQ;
        PH(1)
        {
            ARGP();
            pg8::Gemm g{A_XB, L0 ? A_Wqkv_t : A_Wkvq_t, M, NP, DM, DM}; pg8::StaticOrder S; S.init(M, NP, F.G, (int)blockIdx.x);
            pg8::EpiProj E{A_R1, NQKV, L0 ? A_SS(0) : A_SS(2), 1.0f / DM, EPS, L0 ? A_g_q_a : A_g_k_sh, L0 ? A_g_k_a : A_g_q_b, 0, L0 ? 16 : 4, L0 ? 16 : 8, L0 ? 32 : 24, L0 ? QSCALE : 1.0f, L0 ? 1.0f : QSCALE, EPS,
                           (PG8_LAS float*)(F.lds + att::LDS_LUT)};
            pg8::gemm_phase<pg8::EpiProj, pg8::StaticOrder, true, true>(F.lds + RING_OFF, g, S, E, phase_tid(wave_s));
        }
        GRID_BAR();
        PH(3)
        {
            ARGP(); TIDP();
            if (L0) {
                const int GS = (F.G % 8 == 0) ? F.G / 8 : F.G, xg = F.vcu / GS, lc = F.vcu - xg * GS, NGRP = F.G / GS, HPG = 32 / NGRP, QN = HPG * 64;
                constexpr int NCV = NCONV;
                if (lc >= GS - NCV) { P0_RUN(I_QKV, NITEMS - I_QKV, (xg * NCV + lc - (GS - NCV)) * NWAVES + F.wave, NGRP * NCV * NWAVES); }
                __syncthreads();
                fill_lut(F, A_rel_bias, A_g_q_a, A_g_k_a);
                const float* lq = A_lam_qk;
                float s1 = lq[F.lane] * lq[128 + F.lane] + lq[64 + F.lane] * lq[192 + F.lane], s2 = lq[256 + F.lane] * lq[384 + F.lane] + lq[320 + F.lane] * lq[448 + F.lane];
                s1 = wave_sum(s1, F.lane); s2 = wave_sum(s2, F.lane);
                const float lam = expf(s1) - expf(s2) + LAMBDA_INIT;
                const att::Stg stg = att::make_stg<NQKV>(F.wave, F.lane);
                const att::rsrc_t rs = __builtin_amdgcn_make_buffer_rsrc((void*)A_R1, 0, (int)((size_t)M * NQKV * 2), 0x00020000);
                gu32* qctr = F.ctl + CW_QUEUE + 64 * xg;
                const bf16* Hb = A_H;
                auto ref = [=](int jj, att::Block2& r) { const int hq = jj >> 6, rk = jj & 63, bh = xg * HPG + hq, qb = 63 - rk, b = bh >> 4, hh = bh & 15;
                    const unsigned base = (unsigned)b * (SEQ * NQKV * 2u) + hh * 512u;
                    r.Q = base + (unsigned)qb * (128u * NQKV * 2u); r.K = base + 4096u * 2u; r.V = base + 8192u * 2u;
                    r.O = (bf16*)Hb + ((size_t)b * SEQ + (size_t)qb * 128) * DM + hh * 256; r.P0 = qb * 128; r.map0 = 2 * hh; r.rev = 0; };
                int j;
                if (F.tid == 0) F.MISC[16] = __hip_atomic_fetch_add(qctr, 1u, RLX_AGENT);
                __syncthreads(); j = __builtin_amdgcn_readfirstlane((int)F.MISC[16]); __syncthreads();
                if (j < QN) {
                    att::Block2 cur; ref(j, cur); att::Seam2 S;
                    att::attn2_prime<NQKV>(rs, cur, (char*)lds + RING_OFF, S, stg, F.tid);
                    for (;;) {
                        j = att::attn2_block<NQKV, DM>(rs, cur, (unsigned*)qctr, F.MISC + 16, QN, ref, (char*)lds + RING_OFF, S, stg, F.tid, lam, A_g_sub, 1.0f - LAMBDA_INIT, EPS);
                        if (j >= QN) break;
                        ref(j, cur);
                    }
                }
            } else {
                fill_lut(F, A_rel_bias, A_g_q_b, A_g_k_sh);
                constexpr int NITEM = 2048;
                const att::rsrc_t rs = __builtin_amdgcn_make_buffer_rsrc((void*)A_R1, 0, (int)((size_t)M * NQKV * 2), 0x00020000);
                const att::Stg stg = att::make_stg<NQKV>(F.wave, F.lane);
#define ATT_REF(r, L) do { const int bh = (L) >> 5, qb = (L) & 31, b = bh >> 5, h = bh & 31; const unsigned base = (unsigned)b * (SEQ * NQKV * 2u); \
                r.Q = base + (unsigned)qb * (256u * NQKV * 2u) + (2048u + h * 128u) * 2u; r.K = base + (unsigned)(h >> 2) * 256u; r.V = base + (1024u + (h >> 2) * 128u) * 2u; \
                r.O = A_R2 + ((size_t)b * SEQ + (size_t)qb * 256) * 8192 + h * 128; r.P0 = qb * 256; r.map = h; r.sink2 = A_sinks[h] * LOG2E; } while (0)
                int L = blockIdx.x; asm volatile("" : "+s"(L));
                if (L < NITEM) {
                    att::BlockRef cur; ATT_REF(cur, L); att::Seam S;
                    att::attn_prime<NQKV>(rs, cur, 128, (char*)lds + RING_OFF, S, stg, F.tid);
                    for (;;) {
                        const bool last = L + (int)gridDim.x >= NITEM; const int Ln = last ? L : L + (int)gridDim.x;
                        att::BlockRef nxt = cur; if (!last) ATT_REF(nxt, Ln);
                        att::attn_block<NQKV, 8192>(rs, cur, nxt, SEQ, 128, (char*)lds + RING_OFF, S, stg, F.tid);
                        if (last) break;
                        cur = nxt; L = Ln;
                    }
                }
#undef ATT_REF
            }
        }
        GRID_BAR();
        PH(5)
        {
            ARGP();
            pg8::Gemm g{L0 ? A_H : A_R2, L0 ? A_Woa_t : A_Wob_t, M, DM, DM, L0 ? DM : 8192};     pg8::StaticOrder S; S.init(M, DM, F.G, (int)blockIdx.x);
            pg8::EpiResF32 E{L0 ? A_x : (const float*)nullptr, A_XB, (float*)nullptr, DM, A_XB, L0 ? A_SS(1) : A_SS(3)};
            pg8::gemm_phase<pg8::EpiResF32, pg8::StaticOrder, true, true>(F.lds + RING_OFF, g, S, E, phase_tid(wave_s));
        }
        GRID_BAR();
        PH(7)
        {
            ARGP();
            pg8::Gemm g{A_XB, L0 ? A_Wgu0_t : A_Wgu1_t, M, NGU, DM, DM}; pg8::StaticOrder S; S.init(M, NGU, F.G, (int)blockIdx.x);
            pg8::EpiSwiGLU E{A_R1, DFF, L0 ? A_SS(1) : A_SS(3), 1.0f / DM, EPS};
            pg8::gemm_phase<pg8::EpiSwiGLU, pg8::StaticOrder, true, true>(F.lds + RING_OFF, g, S, E, phase_tid(wave_s));
        }
        GRID_BAR();
        PH(8)
        {
            ARGP();
            pg8::Gemm g{A_R1, L0 ? A_Wd0_t : A_Wd1_t, M, DM, DFF, DFF}; pg8::StaticOrder S; S.init(M, DM, F.G, (int)blockIdx.x, 4);
            pg8::EpiResF32 E{(const float*)nullptr, A_XB, L0 ? (float*)nullptr : A_out, DM, L0 ? A_XB : (bf16*)nullptr, A_SS(2)};
            pg8::gemm_phase<pg8::EpiResF32, pg8::StaticOrder, true, true>(F.lds + RING_OFF, g, S, E, phase_tid(wave_s));
        }
        if (L0) GRID_BAR();
    }
}

extern "C" void kernel_launch(void* const* d_in, const int* in_sizes, int n_in, void* d_out, int out_size, void* d_ws, size_t ws_size, hipStream_t stream) {
    static int grid = 0;
    if (grid == 0) {
        if (n_in != 20 || in_sizes[0] != M * DM || out_size != M * DM || ws_size < WS_END) { fprintf(stderr, "kernel_launch: shape/workspace mismatch: n_in %d in0 %d out %d ws %zu (need %zu)\n", n_in, n_in > 0 ? in_sizes[0] : -1, out_size, ws_size, (size_t)WS_END); grid = -1; return; }
        int dev = 0, cus = 0, per_cu = 0;
        if (hipGetDevice(&dev) != hipSuccess || hipDeviceGetAttribute(&cus, hipDeviceAttributeMultiprocessorCount, dev) != hipSuccess) { grid = -1; return; }
        if (hipFuncSetAttribute((const void*)fwd_kernel, hipFuncAttributeMaxDynamicSharedMemorySize, LDS_BYTES) != hipSuccess) { fprintf(stderr, "kernel_launch: hipFuncSetAttribute failed\n"); grid = -1; return; }
        if (hipOccupancyMaxActiveBlocksPerMultiprocessor(&per_cu, (const void*)fwd_kernel, NWAVES * 64, LDS_BYTES) != hipSuccess || per_cu < 1) { fprintf(stderr, "kernel_launch: occupancy query says %d blocks per CU\n", per_cu); grid = -1; (void)hipGetLastError(); return; }
        grid = cus;
    }
    if (grid < 0) return;
    if (hipMemsetAsync((char*)d_ws + WS_CTL, 0, CTL_ZERO_BYTES, stream) != hipSuccess) return;
    Args a{};
    for (int i = 0; i < 20; ++i) a.in[i] = (const float*)d_in[i];
    a.out = (float*)d_out; a.ws = (unsigned char*)d_ws;
    hipLaunchKernelGGL(fwd_kernel, dim3(grid), dim3(NWAVES * 64), LDS_BYTES, stream, a);
}
```
